# Optimizing an MI355X kernel written in HIP

```python
import jax
import jax.numpy as jnp
from jax import lax
import numpy as np

D_MODEL = 2048
BATCH = 2
SEQ = 4096
DEPTH = 2

D_MIX = D_MODEL
HEAD_DIM = 128
MLSTM_HEADS = D_MIX // 4 // HEAD_DIM
FOX_HEADS = D_MIX // 2 // HEAD_DIM
GDN_HEADS = D_MIX // 4 // HEAD_DIM
MLSTM_W = MLSTM_HEADS * HEAD_DIM
FOX_W = FOX_HEADS * HEAD_DIM
GDN_W = GDN_HEADS * HEAD_DIM
D_FF = -(-8 * D_MODEL // (3 * 256)) * 256
MLSTM_CHUNK = 64
FOX_BLOCK = 128
GDN_CHUNK = 64
CONV_WIDTH = 4
GATE_SOFTCAP = 15.0
NORM_EPS = 1e-6
SPLITS = (MLSTM_W, MLSTM_W, MLSTM_W, MLSTM_W, MLSTM_HEADS, MLSTM_HEADS,
          FOX_W, FOX_W, FOX_W, FOX_HEADS,
          GDN_W, GDN_W, GDN_W, GDN_W, GDN_HEADS, GDN_HEADS)
N_IN = 4 * MLSTM_W + 2 * MLSTM_HEADS + 3 * FOX_W + FOX_HEADS + 4 * GDN_W + 2 * GDN_HEADS

kernel_name = 'hymba_style_mlstm_fox_gdn_hybrid'


def rms_norm(x, w):
    xf = x.astype(jnp.float32)
    y = xf * lax.rsqrt(jnp.mean(xf * xf, axis=-1, keepdims=True) + NORM_EPS)
    return (y * w.astype(jnp.float32)).astype(x.dtype)


def split_columns(t, sizes):
    out = []
    off = 0
    for s in sizes:
        out.append(t[..., off:off + s])
        off += s
    return out


def to_heads(t, n_heads):
    b, s, _ = t.shape
    return t.reshape(b, s, n_heads, -1).transpose(0, 2, 1, 3)


def merge_heads(t):
    b, h, s, d = t.shape
    return t.transpose(0, 2, 1, 3).reshape(b, s, h * d)


def to_chunks(t, size):
    b, h, s = t.shape[:3]
    t = t.reshape(b, h, s // size, size, *t.shape[3:])
    return jnp.moveaxis(t, 2, 0)


def from_chunks(t):
    t = jnp.moveaxis(t, 0, 2)
    b, h, n, l, d = t.shape
    return t.reshape(b, h, n * l, d)


def head_rms_norm(t, w):
    y = t * lax.rsqrt(jnp.mean(t * t, axis=-1, keepdims=True) + NORM_EPS)
    return merge_heads(y) * w.astype(jnp.float32)


def head_layer_norm(t, w):
    mu = jnp.mean(t, axis=-1, keepdims=True)
    c = t - mu
    var = jnp.mean(c * c, axis=-1, keepdims=True)
    return merge_heads(c * lax.rsqrt(var + NORM_EPS)) * w.astype(jnp.float32)


def l2_normalize(t):
    return t * lax.rsqrt(jnp.sum(t * t, axis=-1, keepdims=True) + NORM_EPS)


def soft_cap(t):
    return GATE_SOFTCAP * jnp.tanh(t / GATE_SOFTCAP)


def causal_depthwise_conv(x, w):
    k, c = w.shape
    return lax.conv_general_dilated(x, w[:, None, :], window_strides=(1,), padding=[(k - 1, 0)],
                                    dimension_numbers=('NWC', 'WIO', 'NWC'), feature_group_count=c)


def mlstm_chunkwise(q, k, v, i_pre, f_pre):
    b, h, s, d = q.shape
    L = MLSTM_CHUNK
    k = k * (d ** -0.5)
    logf = jax.nn.log_sigmoid(f_pre)
    qc, kc, vc = to_chunks(q, L), to_chunks(k, L), to_chunks(v, L)
    ic = to_chunks(i_pre, L)
    bc = jnp.cumsum(to_chunks(logf, L), axis=-1)
    causal = jnp.tril(jnp.ones((L, L), dtype=bool))

    def step(carry, xs):
        C, nv, m = carry
        q_, k_, v_, i_, b_ = xs
        log_intra = jnp.where(causal, b_[..., :, None] - b_[..., None, :] + i_[..., None, :], -jnp.inf)
        log_inter = b_ + m[..., None]
        m_t = jnp.maximum(log_inter, jnp.max(log_intra, axis=-1))
        w_inter = jnp.exp(log_inter - m_t)
        p = jnp.exp(log_intra - m_t[..., None]) * jnp.einsum('bhtd,bhsd->bhts', q_, k_)
        num = w_inter[..., None] * jnp.einsum('bhtd,bhde->bhte', q_, C) + jnp.einsum('bhts,bhse->bhte', p, v_)
        den = w_inter * jnp.einsum('bhtd,bhd->bht', q_, nv) + jnp.sum(p, axis=-1)
        h_out = num / jnp.maximum(jnp.abs(den), jnp.exp(-m_t))[..., None]
        b_last = b_[..., -1]
        log_end = b_last[..., None] - b_ + i_
        m_new = jnp.maximum(b_last + m, jnp.max(log_end, axis=-1))
        w_state = jnp.exp(b_last + m - m_new)
        w_end = jnp.exp(log_end - m_new[..., None])
        C = w_state[..., None, None] * C + jnp.einsum('bhs,bhsd,bhse->bhde', w_end, k_, v_)
        nv = w_state[..., None] * nv + jnp.einsum('bhs,bhsd->bhd', w_end, k_)
        return (C, nv, m_new), h_out

    init = (jnp.zeros((b, h, d, d), q.dtype), jnp.zeros((b, h, d), q.dtype), jnp.zeros((b, h), q.dtype))
    _, hs = lax.scan(step, init, (qc, kc, vc, ic, bc))
    return from_chunks(hs)


def forgetting_attention(q, k, v, f_pre):
    b, h, s, d = q.shape
    nb = s // FOX_BLOCK
    c = jnp.cumsum(jax.nn.log_sigmoid(f_pre), axis=-1)
    qb = to_chunks(q * (d ** -0.5), FOX_BLOCK)
    cb = to_chunks(c, FOX_BLOCK)
    starts = jnp.arange(nb, dtype=jnp.int32) * FOX_BLOCK
    kpos = jnp.arange(s, dtype=jnp.int32)

    def block(args):
        q_, c_, start = args
        qpos = start + jnp.arange(FOX_BLOCK, dtype=jnp.int32)
        logits = jnp.einsum('bhqd,bhkd->bhqk', q_, k) + (c_[..., :, None] - c[:, :, None, :])
        logits = jnp.where(kpos[None, :] <= qpos[:, None], logits, -jnp.inf)
        p = jax.nn.softmax(logits, axis=-1)
        return jnp.einsum('bhqk,bhkd->bhqd', p, v)

    return from_chunks(lax.map(block, (qb, cb, starts)))


def gated_delta_rule(q, k, v, g, beta):
    b, h, s, d = q.shape
    L = GDN_CHUNK
    qc, kc, vc = to_chunks(q * (d ** -0.5), L), to_chunks(k, L), to_chunks(v, L)
    gc = jnp.cumsum(to_chunks(g, L), axis=-1)
    bc = to_chunks(beta, L)
    incl = jnp.tril(jnp.ones((L, L), dtype=bool))
    strict = jnp.tril(jnp.ones((L, L), dtype=bool), -1)
    diff = gc[..., :, None] - gc[..., None, :]
    decay = jnp.where(incl, jnp.exp(jnp.where(incl, diff, 0.0)), 0.0)
    kb = kc * bc[..., None]
    a_mat = jnp.where(strict, jnp.einsum('nbhtd,nbhsd->nbhts', kb, kc) * decay, 0.0)
    lhs = a_mat + jnp.eye(L, dtype=a_mat.dtype)
    w_val = lax.linalg.triangular_solve(lhs, vc * bc[..., None], left_side=True, lower=True, unit_diagonal=True)
    w_key = lax.linalg.triangular_solve(lhs, kb * jnp.exp(gc)[..., None], left_side=True, lower=True, unit_diagonal=True)
    attn = jnp.einsum('nbhtd,nbhsd->nbhts', qc, kc) * decay
    q_dec = qc * jnp.exp(gc)[..., None]
    g_last = gc[..., -1]
    k_end = kc * jnp.exp(g_last[..., None] - gc)[..., None]

    def step(state, xs):
        wv, wk, at, qd, ke, gl = xs
        u = wv - jnp.einsum('bhtd,bhde->bhte', wk, state)
        o = jnp.einsum('bhtd,bhde->bhte', qd, state) + jnp.einsum('bhts,bhse->bhte', at, u)
        state = jnp.exp(gl)[..., None, None] * state + jnp.einsum('bhsd,bhse->bhde', ke, u)
        return state, o

    _, os_ = lax.scan(step, jnp.zeros((b, h, d, d), q.dtype), (w_val, w_key, attn, q_dec, k_end, g_last))
    return from_chunks(os_)


def hybrid_mixer(h, w_in, mlstm_i_bias, mlstm_f_bias, fox_f_bias, gdn_conv_w, gdn_a_log, gdn_dt_bias,
                 mlstm_out_norm_w, fox_out_norm_w, gdn_out_norm_w, w_out):
    f32 = jnp.float32
    proj = (h @ w_in).astype(f32)
    (mq, mk, mv, mo, mi, mf, fq, fk, fv, ff, gq, gk, gv, gz, ga, gb) = split_columns(proj, SPLITS)

    mi = soft_cap(mi + mlstm_i_bias.astype(f32)).transpose(0, 2, 1)
    mf = soft_cap(mf + mlstm_f_bias.astype(f32)).transpose(0, 2, 1)
    hm = mlstm_chunkwise(to_heads(mq, MLSTM_HEADS), to_heads(mk, MLSTM_HEADS), to_heads(mv, MLSTM_HEADS), mi, mf)
    y_m = head_layer_norm(hm, mlstm_out_norm_w) * jax.nn.sigmoid(mo)

    hf = forgetting_attention(to_heads(fq, FOX_HEADS), to_heads(fk, FOX_HEADS), to_heads(fv, FOX_HEADS),
                              (ff + fox_f_bias.astype(f32)).transpose(0, 2, 1))
    y_f = head_rms_norm(hf, fox_out_norm_w)

    qkv = jax.nn.silu(causal_depthwise_conv(jnp.concatenate([gq, gk, gv], axis=-1), gdn_conv_w.astype(f32)))
    gq, gk, gv = split_columns(qkv, (GDN_W, GDN_W, GDN_W))
    g = (-jnp.exp(gdn_a_log.astype(f32)) * jax.nn.softplus(ga + gdn_dt_bias.astype(f32))).transpose(0, 2, 1)
    beta = jax.nn.sigmoid(gb).transpose(0, 2, 1)
    hg = gated_delta_rule(l2_normalize(to_heads(gq, GDN_HEADS)), l2_normalize(to_heads(gk, GDN_HEADS)),
                          to_heads(gv, GDN_HEADS), g, beta)
    y_g = head_rms_norm(hg, gdn_out_norm_w) * jax.nn.silu(gz)

    y = jnp.concatenate([y_m, y_f, y_g], axis=-1).astype(h.dtype)
    return y @ w_out


def swiglu(h, w_gate, w_up, w_down):
    return (jax.nn.silu(h @ w_gate) * (h @ w_up)) @ w_down


def setup_inputs(seed: int = 0) -> dict:
    key = jax.random.key(seed)
    ks = jax.random.split(key, 18)
    f32 = jnp.float32
    nrm = lambda k, shape, scale: jax.random.normal(k, shape, f32) * scale
    gain = lambda k, shape: 1.0 + 0.02 * jax.random.normal(k, shape, f32)
    dt = jnp.exp(jax.random.uniform(ks[7], (DEPTH, GDN_HEADS), f32, np.log(1e-3), np.log(1e-1)))
    return {
        'x': jax.random.normal(ks[0], (BATCH, SEQ, D_MODEL), f32),
        'mix_norm_w': gain(ks[1], (DEPTH, D_MODEL)),
        'w_in': nrm(ks[2], (DEPTH, D_MODEL, N_IN), D_MODEL ** -0.5),
        'mlstm_i_bias': nrm(ks[3], (DEPTH, MLSTM_HEADS), 0.1),
        'mlstm_f_bias': jax.random.uniform(ks[4], (DEPTH, MLSTM_HEADS), f32, 3.0, 6.0),
        'fox_f_bias': jax.random.uniform(ks[5], (DEPTH, FOX_HEADS), f32, 2.0, 5.0),
        'gdn_conv_w': nrm(ks[6], (DEPTH, CONV_WIDTH, 3 * GDN_W), CONV_WIDTH ** -0.5),
        'gdn_a_log': jnp.log(jax.random.uniform(ks[8], (DEPTH, GDN_HEADS), f32, 1.0, 16.0)),
        'gdn_dt_bias': dt + jnp.log(-jnp.expm1(-dt)),
        'mlstm_out_norm_w': gain(ks[9], (DEPTH, MLSTM_W)),
        'fox_out_norm_w': gain(ks[10], (DEPTH, FOX_W)),
        'gdn_out_norm_w': gain(ks[11], (DEPTH, GDN_W)),
        'w_out': nrm(ks[12], (DEPTH, D_MIX, D_MODEL), D_MIX ** -0.5),
        'ffn_norm_w': gain(ks[13], (DEPTH, D_MODEL)),
        'w_gate': nrm(ks[14], (DEPTH, D_MODEL, D_FF), D_MODEL ** -0.5),
        'w_up': nrm(ks[15], (DEPTH, D_MODEL, D_FF), D_MODEL ** -0.5),
        'w_down': nrm(ks[16], (DEPTH, D_FF, D_MODEL), D_FF ** -0.5),
        'final_norm_w': gain(ks[17], (D_MODEL,)),
    }


def reference(x, mix_norm_w, w_in, mlstm_i_bias, mlstm_f_bias, fox_f_bias, gdn_conv_w, gdn_a_log, gdn_dt_bias,
              mlstm_out_norm_w, fox_out_norm_w, gdn_out_norm_w, w_out, ffn_norm_w, w_gate, w_up, w_down,
              final_norm_w):
    for l in range(DEPTH):
        h = rms_norm(x, mix_norm_w[l])
        x = x + hybrid_mixer(h, w_in[l], mlstm_i_bias[l], mlstm_f_bias[l], fox_f_bias[l], gdn_conv_w[l],
                             gdn_a_log[l], gdn_dt_bias[l], mlstm_out_norm_w[l], fox_out_norm_w[l],
                             gdn_out_norm_w[l], w_out[l]).astype(x.dtype)
        h = rms_norm(x, ffn_norm_w[l])
        x = x + swiglu(h, w_gate[l], w_up[l], w_down[l]).astype(x.dtype)
    return rms_norm(x, final_norm_w)
```

```cpp
#include <hip/hip_runtime.h>
#include <cstdio>
#include <cstdint>
namespace pg8 {
#define PG8_LAS __attribute__((address_space(3)))
typedef unsigned short bf16_t;
typedef short bf16x8 __attribute__((ext_vector_type(8)));
typedef float f32x4 __attribute__((ext_vector_type(4)));
typedef unsigned u32x4 __attribute__((ext_vector_type(4)));
constexpr int BM = 256, BK = 64, HALF = 128, HTB = HALF * BK * 2  , STAGE_BYTES = 8 * HTB, NXCD = 8, WGM = 8;

__host__ __device__ __forceinline__ int lds_byte(int r, int c) { const int st = (r >> 4) * 2 + (c >> 5), rr = r & 15, cc = c & 31, ob = rr * 64 + cc * 2; return st * 1024 + (ob ^ (((ob >> 9) & 1) << 5)); }
__host__ __device__ __forceinline__ void stage_rc(int b, int& R, int& C) { const int st = b / 1024, sb = b % 1024, swz = sb ^ (((sb >> 9) & 1) << 5); R = (st >> 1) * 16 + swz / 64; C = (st & 1) * 32 + (swz % 64) / 2; }
__host__ __device__ __forceinline__ int perm32(int rho) { const int n = rho >> 4, i = rho & 15; return 8 * (i >> 2) + 4 * n + (i & 3); }

struct Unit { int pm, pn; };
struct Gemm { const bf16_t* A; const bf16_t* Bt; int M, N, K; };

struct StaticOrder {
    int nM, nN, nwg, G, c;
    __host__ __device__ void init(int M, int N, int G_, int c_) { nM = M / BM; nN = N / BM; nwg = nM * nN; G = G_; c = c_; }
    __host__ __device__ bool next(int i, Unit& u) const {
        const long L = (long)i * G + c; if (L >= nwg) return false;
        int wgid = (int)L; { const int q = nwg / NXCD, r = nwg % NXCD, xcd = wgid % NXCD, off = wgid / NXCD; wgid = (xcd < r ? xcd * (q + 1) : r * (q + 1) + (xcd - r) * q) + off; }
        const int nig = WGM * nN, gid = wgid / nig, fm = gid * WGM, gsz = (nM - fm) < WGM ? (nM - fm) : WGM;
        u.pm = fm + ((wgid % nig) % gsz); u.pn = (wgid % nig) / gsz; return true;
    }
    __device__ __forceinline__ void a_ready(const Unit&) const {}
    __device__ __forceinline__ void done(const Unit&) const {}
};

__device__ __forceinline__ unsigned cvt_pk_bf16(float lo, float hi) { unsigned r; asm volatile("v_cvt_pk_bf16_f32 %0, %1, %2" : "=v"(r) : "v"(lo), "v"(hi)); return r; }
typedef float f32x2 __attribute__((ext_vector_type(2)));
struct EpiProj {
    static constexpr bool PERM = true, AFTER_DRAIN = false;
    bf16_t* P; float* GR;
    __device__ __forceinline__ void operator()(const f32x4 (&acc)[2][2][4][2], const Unit& u, int wr, int wc, int fr, int fq) const {
        const int row0 = u.pm * BM + wr * 64 + fr;
        if (u.pn < 28) {
            const int col0 = u.pn * BM + wc * 32 + 8 * fq;
#pragma unroll
            for (int ai = 0; ai < 2; ++ai)
#pragma unroll
                for (int m = 0; m < 4; ++m) { bf16_t* rowp = P + (size_t)(row0 + ai * HALF + m * 16) * 7168 + col0;
#pragma unroll
                    for (int bj = 0; bj < 2; ++bj) { const f32x4 v0 = acc[ai][bj][m][0], v1 = acc[ai][bj][m][1];
                        u32x4 w; w.x = cvt_pk_bf16(v0[0], v0[1]); w.y = cvt_pk_bf16(v0[2], v0[3]); w.z = cvt_pk_bf16(v1[0], v1[1]); w.w = cvt_pk_bf16(v1[2], v1[3]);
                        *(u32x4*)(rowp + bj * HALF) = w; } }
        } else if (wc == 0) {
#pragma unroll
            for (int ai = 0; ai < 2; ++ai)
#pragma unroll
                for (int m = 0; m < 4; ++m) { float* g = GR + (size_t)(row0 + ai * HALF + m * 16) * 32 + 8 * fq;
                    *(f32x4*)g = acc[ai][0][m][0]; *(f32x4*)(g + 4) = acc[ai][0][m][1]; }
        }
    }
};
struct EpiRes {
    static constexpr bool PERM = true, AFTER_DRAIN = false;
    const float* base; float* out;
    __device__ __forceinline__ void operator()(const f32x4 (&acc)[2][2][4][2], const Unit& u, int wr, int wc, int fr, int fq) const {
        const int row0 = u.pm * BM + wr * 64 + fr, col0 = u.pn * BM + wc * 32 + 8 * fq;
#pragma unroll
        for (int ai = 0; ai < 2; ++ai)
#pragma unroll
            for (int m = 0; m < 4; ++m) { const size_t off = (size_t)(row0 + ai * HALF + m * 16) * 2048 + col0;
#pragma unroll
                for (int bj = 0; bj < 2; ++bj) { const f32x4 b0 = *(const f32x4*)(base + off + bj * HALF), b1 = *(const f32x4*)(base + off + bj * HALF + 4);
                    *(f32x4*)(out + off + bj * HALF) = b0 + acc[ai][bj][m][0]; *(f32x4*)(out + off + bj * HALF + 4) = b1 + acc[ai][bj][m][1]; }
                asm volatile("" ::: "memory"); }
    }
};
struct EpiSwiglu {
    static constexpr bool PERM = true, AFTER_DRAIN = false;
    bf16_t* O;
    __device__ __forceinline__ void operator()(const f32x4 (&acc)[2][2][4][2], const Unit& u, int wr, int wc, int fr, int fq) const {
        const int row0 = u.pm * BM + wr * 64 + fr, col0 = u.pn * HALF + wc * 32 + 8 * fq;
#pragma unroll
        for (int ai = 0; ai < 2; ++ai)
#pragma unroll
            for (int m = 0; m < 4; ++m) { bf16_t* rowp = O + (size_t)(row0 + ai * HALF + m * 16) * 5632 + col0;
                float r[8];
#pragma unroll
                for (int n = 0; n < 2; ++n)
#pragma unroll
                    for (int j = 0; j < 4; ++j) { const float g = acc[ai][0][m][n][j], up = acc[ai][1][m][n][j];
                        r[n * 4 + j] = g * __builtin_amdgcn_rcpf(1.0f + __expf(-g)) * up; }
                u32x4 w; w.x = cvt_pk_bf16(r[0], r[1]); w.y = cvt_pk_bf16(r[2], r[3]); w.z = cvt_pk_bf16(r[4], r[5]); w.w = cvt_pk_bf16(r[6], r[7]);
                *(u32x4*)rowp = w; }
    }
};

template <class Epi, class Sched, bool ALIGN_EPI = false, bool SP2 = false>
__device__ __forceinline__ void gemm_phase(PG8_LAS unsigned char* lds, const Gemm g, const Sched& S, const Epi& E) {
    int tid_ = threadIdx.x; asm volatile("" : "+v"(tid_));
    const int tid = tid_, wid = __builtin_amdgcn_readfirstlane(tid >> 6), lane = tid & 63, wr = wid >> 2, wc = wid & 3, fr = lane & 15, fq = lane >> 4;
    const int K = g.K, nt = K / BK;
    unsigned voffA[2], voffB[2];
#pragma unroll
    for (int i = 0; i < 2; ++i) { int R, C; stage_rc(tid * 16 + i * 8192, R, C); const int Rb = Epi::PERM ? ((R & ~31) + perm32(R & 31)) : R;
        voffA[i] = (unsigned)(R * K + C) * 2u; voffB[i] = (unsigned)(Rb * K + C) * 2u; }
    const size_t kstep = (size_t)(BK * 2);
    const size_t hstep = (size_t)HALF * K * 2;
    const size_t tstep = 2 * hstep;
    const unsigned ldsw = (unsigned)wid * 1024u;
    const int aoff = lds_byte(wr * 64 + fr, fq * 8), boff = lds_byte(wc * 32 + fr, fq * 8);
#define PG8_SA(b, h) (((b) * 2 + (h)) * HTB)
#define PG8_SB(b, h) ((4 + (b) * 2 + (h)) * HTB)
#define PG8_STAGE(bufoff, gbase, voff) do { _Pragma("unroll") for (int _i = 0; _i < 2; ++_i) \
        __builtin_amdgcn_global_load_lds((const unsigned*)((const char*)(gbase) + (voff)[_i]), (PG8_LAS unsigned*)(lds + (bufoff) + ldsw + _i * 8192), 16, 0, 0); } while (0)
#define PG8_LDA(dst, b, h) do { _Pragma("unroll") for (int m = 0; m < 4; ++m) _Pragma("unroll") for (int k = 0; k < 2; ++k) dst[m][k] = *(const PG8_LAS bf16x8*)(lds + PG8_SA(b, h) + aoff + m * 2048 + k * 1024); } while (0)
#define PG8_LDB(dst, b, h) do { _Pragma("unroll") for (int n = 0; n < 2; ++n) _Pragma("unroll") for (int k = 0; k < 2; ++k) dst[n][k] = *(const PG8_LAS bf16x8*)(lds + PG8_SB(b, h) + boff + n * 2048 + k * 1024); } while (0)
#define PG8_MMA(ai, bj, At, Bt) do { __builtin_amdgcn_s_setprio(1); _Pragma("unroll") for (int m = 0; m < 4; ++m) _Pragma("unroll") for (int n = 0; n < 2; ++n) _Pragma("unroll") for (int k = 0; k < 2; ++k) \
        acc[ai][bj][m][n] = __builtin_amdgcn_mfma_f32_16x16x32_bf16(Bt[n][k], At[m][k], acc[ai][bj][m][n], 0, 0, 0); __builtin_amdgcn_s_setprio(0); } while (0)
#define PG8_WAIT_V(n) asm volatile("s_waitcnt vmcnt(" #n ")" ::: "memory")
#define PG8_WAIT_L(n) asm volatile("s_waitcnt lgkmcnt(" #n ")" ::: "memory")
#define PG8_BAR __builtin_amdgcn_s_barrier()
#define PG8_SCHED __builtin_amdgcn_sched_barrier(0)
    Unit cur, nxt; int ui = 0;
    if (!S.next(0, cur)) return;
    f32x4 acc[2][2][4][2];
#pragma unroll
    for (int a = 0; a < 2; ++a)
#pragma unroll
        for (int b = 0; b < 2; ++b)
#pragma unroll
            for (int m = 0; m < 4; ++m)
#pragma unroll
                for (int n = 0; n < 2; ++n) acc[a][b][m][n] = (f32x4){0.f, 0.f, 0.f, 0.f};
    bf16x8 At[4][2], B0[2][2], B1[2][2];
    const char* cA = (const char*)g.A + (size_t)cur.pm * tstep; const char* cB = (const char*)g.Bt + (size_t)cur.pn * tstep;
    S.a_ready(cur);
    if constexpr (SP2) {
        PG8_STAGE(PG8_SB(0, 0), cB, voffB); PG8_STAGE(PG8_SB(0, 1), cB + hstep, voffB); PG8_STAGE(PG8_SA(0, 0), cA, voffA); PG8_STAGE(PG8_SA(0, 1), cA + hstep, voffA);
        if (wr == 1) PG8_BAR;
        PG8_WAIT_V(2); PG8_BAR;
        PG8_STAGE(PG8_SB(1, 0), cB + kstep, voffB); PG8_STAGE(PG8_SA(1, 0), cA + kstep, voffA); PG8_STAGE(PG8_SB(1, 1), cB + hstep + kstep, voffB);
        PG8_WAIT_V(6); PG8_BAR;
    } else {
        PG8_STAGE(PG8_SB(0, 0), cB, voffB); PG8_STAGE(PG8_SA(0, 0), cA, voffA); PG8_STAGE(PG8_SB(0, 1), cB + hstep, voffB); PG8_STAGE(PG8_SA(0, 1), cA + hstep, voffA);
        if (wr == 1) PG8_BAR;
        PG8_WAIT_V(4); PG8_BAR;
        PG8_STAGE(PG8_SB(1, 0), cB + kstep, voffB); PG8_STAGE(PG8_SA(1, 0), cA + kstep, voffA); PG8_STAGE(PG8_SB(1, 1), cB + hstep + kstep, voffB);
        PG8_WAIT_V(6); PG8_BAR;
    }
    for (;;) {
        const bool has_next = S.next(ui + 1, nxt);
        const char* nA = has_next ? (const char*)g.A + (size_t)nxt.pm * tstep : cA; const char* nB = has_next ? (const char*)g.Bt + (size_t)nxt.pn * tstep : cB;
        for (int t = 0; t < nt; t += 2) {
            const bool last = (t == nt - 2);
            const char* a1 = cA + (size_t)(t + 1) * kstep;
            const char* a2 = last ? nA : cA + (size_t)(t + 2) * kstep; const char* b2 = last ? nB : cB + (size_t)(t + 2) * kstep;
            const char* a3 = a2 + kstep; const char* b3 = b2 + kstep;
            if (last && has_next) S.a_ready(nxt);
            if constexpr (SP2) {
            PG8_LDB(B0, 0, 0); PG8_LDB(B1, 0, 1); PG8_SCHED; PG8_LDA(At, 0, 0); PG8_STAGE(PG8_SA(1, 1), a1 + hstep, voffA);
            PG8_WAIT_V(8); PG8_WAIT_L(0); PG8_BAR; PG8_MMA(0, 0, At, B0); PG8_MMA(0, 1, At, B1); PG8_BAR; PG8_SCHED;
            PG8_LDA(At, 0, 1); PG8_STAGE(PG8_SB(0, 0), b2, voffB); PG8_STAGE(PG8_SB(0, 1), b2 + hstep, voffB); PG8_STAGE(PG8_SA(0, 0), a2, voffA);
            PG8_WAIT_V(8); PG8_WAIT_L(0); PG8_BAR; PG8_MMA(1, 0, At, B0); PG8_MMA(1, 1, At, B1); PG8_BAR; PG8_SCHED;
            PG8_LDB(B0, 1, 0); PG8_LDB(B1, 1, 1); PG8_SCHED; PG8_LDA(At, 1, 0); PG8_STAGE(PG8_SA(0, 1), a2 + hstep, voffA);
            PG8_WAIT_V(8); PG8_WAIT_L(0); PG8_BAR; PG8_MMA(0, 0, At, B0); PG8_MMA(0, 1, At, B1); PG8_BAR; PG8_SCHED;
            PG8_LDA(At, 1, 1); PG8_STAGE(PG8_SB(1, 0), b3, voffB); PG8_STAGE(PG8_SB(1, 1), b3 + hstep, voffB); PG8_STAGE(PG8_SA(1, 0), a3, voffA);
            PG8_WAIT_V(8); PG8_WAIT_L(0); PG8_BAR; PG8_MMA(1, 0, At, B0); PG8_MMA(1, 1, At, B1); PG8_BAR; PG8_SCHED;
            } else {
            PG8_LDB(B0, 0, 0); PG8_SCHED; PG8_LDA(At, 0, 0); PG8_STAGE(PG8_SA(1, 1), a1 + hstep, voffA);
            PG8_WAIT_L(8); PG8_BAR; PG8_WAIT_L(0); PG8_MMA(0, 0, At, B0); PG8_BAR; PG8_SCHED;
            PG8_LDB(B1, 0, 1); PG8_STAGE(PG8_SB(0, 0), b2, voffB);
            PG8_BAR; PG8_WAIT_L(0); PG8_MMA(0, 1, At, B1); PG8_BAR;
            PG8_LDA(At, 0, 1); PG8_STAGE(PG8_SA(0, 0), a2, voffA);
            PG8_BAR; PG8_WAIT_L(0); PG8_MMA(1, 0, At, B0); PG8_BAR; PG8_SCHED;
            PG8_STAGE(PG8_SB(0, 1), b2 + hstep, voffB);
            PG8_WAIT_V(6); PG8_BAR; PG8_MMA(1, 1, At, B1); PG8_BAR;
            PG8_LDB(B0, 1, 0); PG8_SCHED; PG8_LDA(At, 1, 0); PG8_STAGE(PG8_SA(0, 1), a2 + hstep, voffA);
            PG8_WAIT_L(8); PG8_BAR; PG8_WAIT_L(0); PG8_MMA(0, 0, At, B0); PG8_BAR; PG8_SCHED;
            PG8_LDB(B1, 1, 1); PG8_STAGE(PG8_SB(1, 0), b3, voffB);
            PG8_BAR; PG8_WAIT_L(0); PG8_MMA(0, 1, At, B1); PG8_BAR;
            PG8_LDA(At, 1, 1); PG8_STAGE(PG8_SA(1, 0), a3, voffA);
            PG8_BAR; PG8_WAIT_L(0); PG8_MMA(1, 0, At, B0); PG8_BAR; PG8_SCHED;
            PG8_STAGE(PG8_SB(1, 1), b3 + hstep, voffB);
            PG8_WAIT_V(6); PG8_BAR; PG8_MMA(1, 1, At, B1); PG8_BAR;
            }
        }
        if constexpr (ALIGN_EPI) { if (wr == 0) PG8_BAR; }
        if constexpr (!Epi::AFTER_DRAIN) { E(acc, cur, wr, wc, fr, fq); S.done(cur); }
        if (!has_next) break;
#pragma unroll
        for (int a = 0; a < 2; ++a)
#pragma unroll
            for (int b = 0; b < 2; ++b)
#pragma unroll
                for (int m = 0; m < 4; ++m)
#pragma unroll
                    for (int n = 0; n < 2; ++n) acc[a][b][m][n] = (f32x4){0.f, 0.f, 0.f, 0.f};
        cur = nxt; cA = nA; cB = nB; ++ui;
        if constexpr (ALIGN_EPI) { if (wr == 1) PG8_BAR; }
    }
    PG8_WAIT_V(0);
    if constexpr (!ALIGN_EPI) { if (wr == 0) PG8_BAR; }
    PG8_BAR;
    if constexpr (Epi::AFTER_DRAIN) { E.fused(acc, cur, wr, wc, fr, fq, lds, wid, lane); S.done(cur); }
#undef PG8_SA
#undef PG8_SB
#undef PG8_STAGE
#undef PG8_LDA
#undef PG8_LDB
#undef PG8_MMA
#undef PG8_WAIT_V
#undef PG8_WAIT_L
#undef PG8_BAR
#undef PG8_SCHED
}
}
namespace fox {
typedef unsigned short bf16;
typedef short bf16x8 __attribute__((ext_vector_type(8)));
typedef short s16x4 __attribute__((ext_vector_type(4)));
typedef float f32x16 __attribute__((ext_vector_type(16)));
typedef float f32x4 __attribute__((ext_vector_type(4)));
typedef unsigned u32x4 __attribute__((ext_vector_type(4)));
constexpr int D = 128, LDQ = 7168, LDO = 1024;
constexpr float SCALE = 0.08838834764831845f, THR = 8.f;
constexpr int NW = 8, QBLK = 32, KVBLK = 64, QB = NW * QBLK;
constexpr int SHM_V = KVBLK * D * 2, SHM_K = KVBLK * D * 2;
constexpr int OFF_WS = 2 * SHM_V + 2 * SHM_K, OFF_B = OFF_WS + NW * 64 * 4, LDS_BYTES = OFF_B + 2 * 256;
#define KSWZ(row, colB) ((row) * 256 + ((colB) ^ (((row) & 7) << 4)))
#define SBAR() __builtin_amdgcn_sched_barrier(0)
__device__ __forceinline__ int v_st(int k, int c) { const int kk = (k & ~0xC) | ((k & 4) << 1) | ((k & 8) >> 1); return ((kk >> 3) * 4 + (c >> 5)) * 512 + ((kk & 7) * 32 + (c & 31)) * 2; }
__device__ __forceinline__ int v_rd_base(int lane) { return ((lane & 3) << 3) | (((lane >> 2) & 3) << 6) | (((lane >> 4) & 1) << 5) | (((lane >> 5) & 1) << 8); }
constexpr int v_rd_off(int d0, int ks, int half) { return d0 * 512 + ks * 4096 + half * 2048; }
__device__ __forceinline__ int crow(int r, int hi) { return (r & 3) + 8 * (r >> 2) + 4 * hi; }
__device__ __forceinline__ unsigned cvtpk(float lo, float hi) { unsigned r; asm volatile("v_cvt_pk_bf16_f32 %0, %1, %2" : "=v"(r) : "v"(lo), "v"(hi)); return r; }
__device__ __forceinline__ bf16x8 load8(const bf16* p) { return *reinterpret_cast<const bf16x8*>(p); }
__device__ __forceinline__ void mask_tile(f32x16& p0, f32x16& p1, int dq) {
    const float NEG = -__builtin_inff();
#pragma unroll
    for (int r = 0; r < 16; ++r) { const int c = (r & 3) + 8 * (r >> 2);
        if (dq - c < 0) p0[r] = NEG;
        if (dq - c - 32 < 0) p1[r] = NEG; }
}
__device__ __forceinline__ void partialSM(f32x16& p0, f32x16& p1, float& m_reg, float& mn, float& alpha) {
    float pmax = p0[0];
#pragma unroll
    for (int r = 1; r < 16; ++r) pmax = fmaxf(pmax, p0[r]);
#pragma unroll
    for (int r = 0; r < 16; ++r) pmax = fmaxf(pmax, p1[r]);
    { auto rr = __builtin_amdgcn_permlane32_swap(__float_as_uint(pmax), __float_as_uint(pmax), false, false);
      pmax = fmaxf(__uint_as_float(rr[0]), __uint_as_float(rr[1])); }
    constexpr float C2 = 1.4426950408889634f * SCALE;
    if (__builtin_expect(__all((pmax - m_reg) * SCALE <= THR), 1)) { mn = m_reg; alpha = 1.f; }
    else { mn = fmaxf(m_reg, pmax); alpha = __builtin_amdgcn_exp2f((m_reg - mn) * C2); m_reg = mn; }
    const float mnL = -mn * C2;
#pragma unroll
    for (int r = 0; r < 16; ++r) p0[r] = fmaf(p0[r], C2, mnL);
#pragma unroll
    for (int r = 0; r < 16; ++r) p1[r] = fmaf(p1[r], C2, mnL);
#pragma unroll
    for (int r = 0; r < 16; ++r) p0[r] = __builtin_amdgcn_exp2f(p0[r]);
}
__device__ __forceinline__ void finishSM(f32x16& p0, f32x16& p1, float alpha, float& l_reg, bf16x8& pa0, bf16x8& pa1, bf16x8& pa2, bf16x8& pa3) {
#pragma unroll
    for (int r = 0; r < 16; ++r) p1[r] = __builtin_amdgcn_exp2f(p1[r]);
    float ps = 0;
#pragma unroll
    for (int r = 0; r < 16; ++r) ps += p0[r];
#pragma unroll
    for (int r = 0; r < 16; ++r) ps += p1[r];
    { auto rr = __builtin_amdgcn_permlane32_swap(__float_as_uint(ps), __float_as_uint(ps), false, false);
      ps = __uint_as_float(rr[0]) + __uint_as_float(rr[1]); }
    l_reg = l_reg * alpha + ps;
#define PK4(P, B_, OUT) do { unsigned a0 = cvtpk(P[B_+0], P[B_+1]), a1 = cvtpk(P[B_+2], P[B_+3]);                          \
        unsigned b0 = cvtpk(P[B_+4], P[B_+5]), b1 = cvtpk(P[B_+6], P[B_+7]);                                             \
        auto r0 = __builtin_amdgcn_permlane32_swap(a0, b0, false, false); auto r1 = __builtin_amdgcn_permlane32_swap(a1, b1, false, false); \
        u32x4 w = {r0[0], r1[0], r0[1], r1[1]}; OUT = *reinterpret_cast<bf16x8*>(&w); } while (0)
    PK4(p0, 0, pa0); PK4(p0, 8, pa1); PK4(p1, 0, pa2); PK4(p1, 8, pa3);
#undef PK4
}
template <int KB>
__device__ __forceinline__ void qkt(f32x16& p0, f32x16& p1, const char* K_lds, const char* B_lds, int r32, int hi, const bf16x8* qr) {
    { const f32x4* bl = reinterpret_cast<const f32x4*>(B_lds + KB * 256) + hi;
#pragma unroll
      for (int g = 0; g < 4; ++g) { const f32x4 a = bl[2 * g], b = bl[8 + 2 * g];
          p0[4 * g + 0] = a[0]; p0[4 * g + 1] = a[1]; p0[4 * g + 2] = a[2]; p0[4 * g + 3] = a[3];
          p1[4 * g + 0] = b[0]; p1[4 * g + 1] = b[1]; p1[4 * g + 2] = b[2]; p1[4 * g + 3] = b[3]; } }
    const char* kb[4];
#pragma unroll
    for (int dd = 0; dd < 4; ++dd) kb[dd] = K_lds + KB * SHM_K + KSWZ(r32, (dd * 16 + hi * 8) * 2);
#pragma unroll
    for (int d0 = 0; d0 < 8; ++d0) { const char* a = kb[d0 & 3] + (d0 >> 2) * 128;
        bf16x8 b0 = *reinterpret_cast<const bf16x8*>(a);
        bf16x8 b1 = *reinterpret_cast<const bf16x8*>(a + 32 * 256);
        p0 = __builtin_amdgcn_mfma_f32_32x32x16_bf16(b0, qr[d0], p0, 0, 0, 0);
        p1 = __builtin_amdgcn_mfma_f32_32x32x16_bf16(b1, qr[d0], p1, 0, 0, 0); }
}
template <int VB>
__device__ __forceinline__ void pv_tile(f32x16* o, int vb0, bf16x8 pa0, bf16x8 pa1, bf16x8 pa2, bf16x8 pa3) {
#define TRRD(dst, off) asm volatile("ds_read_b64_tr_b16 %0, %1 offset:%2" : "=&v"(dst) : "v"(vb0), "i"(off) : "memory")
#define PV_D0(d0) do { s16x4 l0, l1, l2, l3, h0, h1, h2, h3; constexpr int b_ = VB * SHM_V + v_rd_off(d0, 0, 0); \
        TRRD(l0, b_); TRRD(h0, b_ + 2048); TRRD(l1, b_ + 4096); TRRD(h1, b_ + 6144); TRRD(l2, b_ + 8192); TRRD(h2, b_ + 10240); TRRD(l3, b_ + 12288); TRRD(h3, b_ + 14336); \
        asm volatile("s_waitcnt lgkmcnt(0)" ::: "memory"); SBAR(); \
        o[d0] = __builtin_amdgcn_mfma_f32_32x32x16_bf16(pa0, (bf16x8){l0[0], l0[1], l0[2], l0[3], h0[0], h0[1], h0[2], h0[3]}, o[d0], 0, 0, 0);   \
        o[d0] = __builtin_amdgcn_mfma_f32_32x32x16_bf16(pa1, (bf16x8){l1[0], l1[1], l1[2], l1[3], h1[0], h1[1], h1[2], h1[3]}, o[d0], 0, 0, 0);   \
        o[d0] = __builtin_amdgcn_mfma_f32_32x32x16_bf16(pa2, (bf16x8){l2[0], l2[1], l2[2], l2[3], h2[0], h2[1], h2[2], h2[3]}, o[d0], 0, 0, 0);   \
        o[d0] = __builtin_amdgcn_mfma_f32_32x32x16_bf16(pa3, (bf16x8){l3[0], l3[1], l3[2], l3[3], h3[0], h3[1], h3[2], h3[3]}, o[d0], 0, 0, 0); } while (0)
    PV_D0(0); PV_D0(1); PV_D0(2); PV_D0(3);
#undef PV_D0
#undef TRRD
}
struct BlockRef { const bf16* Q; const bf16* K; const bf16* V; const float* CB; float* O; int P0; };
struct Seam { bf16x8 qr[8]; bf16x8 st_v0, st_v1, st_k0, st_k1; };
#define ROW(p, k0, rr) ((p) + (size_t)((k0) + (rr)) * LDQ + sc)
#define VMW() asm volatile("s_waitcnt vmcnt(0)" ::: "memory")
#define VMWN(n) asm volatile("s_waitcnt vmcnt(%0)" :: "i"(n) : "memory")
#define SLOAD_H(Kp, Vp, k0) do { S.st_v0 = load8(ROW(Vp, k0, sr)); S.st_v1 = load8(ROW(Vp, k0, 32 + sr));              \
                         S.st_k0 = load8(ROW(Kp, k0, sr)); S.st_k1 = load8(ROW(Kp, k0, 32 + sr)); } while (0)
#define SWRITE_HK(bf) do { *(bf16x8*)(K_lds + (bf) * SHM_K + kws) = S.st_k0; *(bf16x8*)(K_lds + (bf) * SHM_K + kws + 32 * 256) = S.st_k1; } while (0)
#define BDMA(Bp, k0, bf) do { if (wid == 0) __builtin_amdgcn_global_load_lds((const unsigned*)((Bp) + (k0) + lane), (__attribute__((address_space(3))) unsigned*)(unsigned)(uintptr_t)(B_lds + (bf) * 256), 4, 0, 0); } while (0)
#define SWRITE_HV(bf) do { *(bf16x8*)(V_lds + (bf) * SHM_V + vst0) = S.st_v0; *(bf16x8*)(V_lds + (bf) * SHM_V + vst1) = S.st_v1; } while (0)
#define SWRITE_H(bf) do { SWRITE_HV(bf); SWRITE_HK(bf); } while (0)
__device__ __forceinline__ void prime(const BlockRef& cur, char* lds, Seam& S) {
    int tid_ = threadIdx.x; asm volatile("" : "+v"(tid_));
    const int tid = tid_, wid = __builtin_amdgcn_readfirstlane(tid >> 6), lane = tid & 63, r32 = lane & 31, hi = lane >> 5;
    const int sr = tid >> 4, sc = (tid & 15) * 8, kws = KSWZ(sr, sc * 2); char* K_lds = lds + 2 * SHM_V; char* B_lds = lds + OFF_B;
#pragma unroll
    for (int d0 = 0; d0 < 8; ++d0) S.qr[d0] = load8(cur.Q + (size_t)(wid * QBLK + r32) * LDQ + d0 * 16 + hi * 8);
    BDMA(cur.CB, 0, 0); SLOAD_H(cur.K, cur.V, 0); VMW(); SWRITE_HK(0);
    __syncthreads();
}
__device__ __forceinline__ void block(const BlockRef& cur, char* lds, Seam& S) {
    int tid_ = threadIdx.x; asm volatile("" : "+v"(tid_));
    const int tid = tid_, wid = __builtin_amdgcn_readfirstlane(tid >> 6), lane = tid & 63, r32 = lane & 31, hi = lane >> 5;
    const int NT = (cur.P0 + QB - 1) / KVBLK + 1;
    const int qlo = cur.P0 + wid * QBLK, qm = qlo + r32 - 4 * hi;
    char* V_lds = lds; char* K_lds = lds + 2 * SHM_V; char* B_lds = lds + OFF_B;
    float* ws = (float*)(lds + OFF_WS) + wid * 64; float* li_l = ws, * al_l = ws + 32;
    float m_reg = -1e30f, l_reg = 0; f32x16 o[4] = {};
    const int sr = tid >> 4, sc = (tid & 15) * 8, vst0 = v_st(sr, sc), vst1 = v_st(32 + sr, sc), kws = KSWZ(sr, sc * 2);
    const int vb0 = (int)(uintptr_t)V_lds + v_rd_base(lane);
    const bf16* Kh = cur.K; const bf16* Vh = cur.V; const float* Bh = cur.CB;
#define RESC(a) do { if (__any((a) < 1.f)) { if (hi == 0) al_l[r32] = (a); asm volatile("s_waitcnt lgkmcnt(0)" ::: "memory");              \
                     for (int d_ = 0; d_ < 4; ++d_) for (int r = 0; r < 16; ++r) o[d_][r] *= al_l[crow(r, hi)]; } } while (0)
#define KBASE(t) ((t) * KVBLK)
#define MASKT(P0_, P1_, t) do { const int kb_ = KBASE(t); if (kb_ + KVBLK - 1 > qlo) mask_tile(P0_, P1_, qm - kb_); } while (0)
    f32x16 pA0, pA1, pB0, pB1; float mnA, mnB, alA, alB; bf16x8 pa0, pa1, pa2, pa3;
    SWRITE_HV(0); SBAR();
    if (NT > 1) { BDMA(Bh, KBASE(1), 1); SLOAD_H(Kh, Vh, KBASE(1)); }
    SBAR(); qkt<0>(pA0, pA1, K_lds, B_lds, r32, hi, S.qr);
    MASKT(pA0, pA1, 0); partialSM(pA0, pA1, m_reg, mnA, alA);
    if (NT > 1) { VMW(); SWRITE_H(1); }
    __syncthreads();
#define HALF_STEP(PX0, PX1, mnX, alX, PY0, PY1, alY, t, KB, VB, SB) do {                                                      \
        SBAR(); qkt<KB>(PX0, PX1, K_lds, B_lds, r32, hi, S.qr);                                                              \
        finishSM(PY0, PY1, alY, l_reg, pa0, pa1, pa2, pa3); SBAR();                                                           \
        if ((t) + 1 < NT) { BDMA(Bh, KBASE((t) + 1), SB); SLOAD_H(Kh, Vh, KBASE((t) + 1)); SBAR(); }                          \
        pv_tile<VB>(o, vb0, pa0, pa1, pa2, pa3); MASKT(PX0, PX1, (t)); partialSM(PX0, PX1, m_reg, mnX, alX);                  \
        __syncthreads();                                                                                                      \
        if ((t) + 1 < NT) { VMW(); SWRITE_H(SB); }                                                                            \
        RESC(alX); __syncthreads(); } while (0)
    for (int t = 1; t + 1 < NT; t += 2) {
        HALF_STEP(pB0, pB1, mnB, alB, pA0, pA1, alA, t, 1, 0, 0);
        HALF_STEP(pA0, pA1, mnA, alA, pB0, pB1, alB, t + 1, 0, 1, 1);
    }
    const bool even = (NT & 1) == 0;
    if (even) { SBAR(); qkt<1>(pB0, pB1, K_lds, B_lds, r32, hi, S.qr); SBAR(); }
    finishSM(pA0, pA1, alA, l_reg, pa0, pa1, pa2, pa3); SBAR();
    pv_tile<0>(o, vb0, pa0, pa1, pa2, pa3);
    if (even) { MASKT(pB0, pB1, NT - 1); partialSM(pB0, pB1, m_reg, mnB, alB); __syncthreads(); RESC(alB);
        finishSM(pB0, pB1, alB, l_reg, pa0, pa1, pa2, pa3); SBAR(); pv_tile<1>(o, vb0, pa0, pa1, pa2, pa3); }
    if (hi == 0) li_l[r32] = l_reg; asm volatile("s_waitcnt lgkmcnt(0)" ::: "memory");
    float rli[16];
#pragma unroll
    for (int r = 0; r < 16; ++r) rli[r] = __builtin_amdgcn_rcpf(li_l[crow(r, hi)]);
    float* Ow = cur.O + (size_t)(wid * QBLK) * LDO;
#pragma unroll
    for (int r = 0; r < 16; ++r) { const int orow = crow(r, hi);
#pragma unroll
        for (int d0 = 0; d0 < 4; ++d0) Ow[(size_t)orow * LDO + d0 * 32 + r32] = o[d0][r] * rli[r]; }
    __syncthreads();
#undef RESC
#undef KBASE
#undef MASKT
#undef HALF_STEP
}
#undef ROW
#undef VMW
#undef VMWN
#undef SLOAD_H
#undef SWRITE_HK
#undef SWRITE_HV
#undef BDMA
#undef SWRITE_H
#undef KSWZ
#undef SBAR
}

#define GAS __attribute__((address_space(1)))
#define LAS __attribute__((address_space(3)))
typedef unsigned short bf16;
typedef unsigned v4u __attribute__((ext_vector_type(4)));
typedef float f32x4 __attribute__((ext_vector_type(4)));
typedef short bf16x8 __attribute__((ext_vector_type(8)));
typedef GAS unsigned gu32;
typedef GAS unsigned long long gu64;
#define RLX_AGENT __ATOMIC_RELAXED, __HIP_MEMORY_SCOPE_AGENT
#define LDS_WAIT() asm volatile("s_waitcnt lgkmcnt(0)" ::: "memory")
#define VM_WAIT() asm volatile("s_waitcnt vmcnt(0)" ::: "memory")
__device__ __forceinline__ unsigned long long rt() { return __builtin_amdgcn_s_memrealtime(); }
__device__ __forceinline__ unsigned f2bf(float f) { unsigned u = __builtin_bit_cast(unsigned, f); return (u + 0x7fffu + ((u >> 16) & 1u)) >> 16; }
__device__ __forceinline__ unsigned pk2(float lo, float hi) { return f2bf(lo) | (f2bf(hi) << 16); }

#define XB_TMO      128
#define XB_XCNT(j)  (256  + 64 * (j))
#define XB_XSUB(j)  (1280 + 64 * (j))
#define XB_XGEN(j)  (2304 + 64 * (j))
#define XB_TOP      3328
#define XB_TOPGEN   3392
#define XCD_BAR_WORDS 3456
#define XB_SPIN_CAP (1u << 18)

__device__ __forceinline__ unsigned xb_ld(unsigned* p)              { return __hip_atomic_load(p, __ATOMIC_RELAXED, __HIP_MEMORY_SCOPE_AGENT); }
__device__ __forceinline__ unsigned xb_add(unsigned* p, unsigned v) { return __hip_atomic_fetch_add(p, v, __ATOMIC_RELAXED, __HIP_MEMORY_SCOPE_AGENT); }
__device__ __forceinline__ unsigned xb_xcc_id() { return (unsigned)__builtin_amdgcn_s_getreg((3 << 11) | 20) & 0xFu; }
#define XB_SPIN(cond, bar) do { unsigned _sp = 0; while (cond) { __builtin_amdgcn_s_sleep(1); \
    if ((++_sp & 255u) == 0u) { if (xb_ld(&(bar)[XB_TMO])) break; if (_sp > XB_SPIN_CAP) { atomicAdd(&(bar)[XB_TMO], 1u); break; } } } } while (0)

struct XcdBarrier {
    unsigned* bar; unsigned x;
    volatile LAS unsigned* st;
};

__device__ __forceinline__ XcdBarrier xcd_barrier_post(unsigned* bar, volatile LAS unsigned* st) {
    XcdBarrier b; b.bar = bar; b.x = xb_xcc_id(); b.st = st;
    if (threadIdx.x == 0) (void)xb_add(&bar[XB_XCNT(b.x)], 1u);
    return b;
}
__device__ __forceinline__ void xcd_barrier_complete(unsigned* bar, unsigned x, unsigned& nloc, unsigned& nx) {
    const unsigned G = gridDim.x * gridDim.y * gridDim.z;
    unsigned sum, cnt, mine, sp = 0u;
    for (;;) {
        sum = 0u; cnt = 0u; mine = 0u;
#pragma unroll
        for (unsigned j = 0; j < 16; ++j) { const unsigned c = xb_ld(&bar[XB_XCNT(j)]); sum += c; cnt += (c > 0u) ? 1u : 0u; mine = (j == x) ? c : mine; }
        if (sum == G) break;
        __builtin_amdgcn_s_sleep(1);
        if ((++sp & 255u) == 0u) { if (xb_ld(&bar[XB_TMO])) break; if (sp > XB_SPIN_CAP) { atomicAdd(&bar[XB_TMO], 1u); break; } }
    }
    nloc = mine > 0u ? mine : 1u; nx = cnt > 0u ? cnt : 1u;
}

__device__ __forceinline__ void xcd_barrier(const XcdBarrier& b) {
    asm volatile("s_waitcnt vmcnt(0)" ::: "memory");
    __syncthreads();
    if (threadIdx.x == 0) {
        unsigned* bar = b.bar;
        __builtin_amdgcn_s_waitcnt(0);
        unsigned nloc = b.st[0], nx = b.st[1];
        if (nloc == 0u) { xcd_barrier_complete(bar, b.x, nloc, nx); b.st[0] = nloc; b.st[1] = nx; }
        const unsigned old = xb_add(&bar[XB_XSUB(b.x)], 1u);
        const unsigned gen = old / nloc;
        if (old + 1u == (gen + 1u) * nloc) {
            __builtin_amdgcn_fence(__ATOMIC_RELEASE, "agent");
            asm volatile("s_waitcnt vmcnt(0)" ::: "memory");
            const unsigned og = xb_add(&bar[XB_TOP], 1u);
            const unsigned tg = og / nx;
            if (og + 1u == (tg + 1u) * nx) xb_add(&bar[XB_TOPGEN], 1u);
            else XB_SPIN(xb_ld(&bar[XB_TOPGEN]) == tg, bar);
            __builtin_amdgcn_fence(__ATOMIC_ACQUIRE, "agent");
            xb_add(&bar[XB_XGEN(b.x)], 1u);
            asm volatile("s_waitcnt vmcnt(0)" ::: "memory");
        } else {
            XB_SPIN(xb_ld(&bar[XB_XGEN(b.x)]) == gen, bar);
            __builtin_amdgcn_fence(__ATOMIC_ACQUIRE, "agent");
            asm volatile("s_waitcnt vmcnt(0)" ::: "memory");
        }
    }
    __syncthreads();
}
constexpr int NWAVES = 8;
constexpr int DM = 2048, SEQ = 4096, NB = 2, M = NB * SEQ, DEPTH = 2, NIN = 7192, DFF = 5632;
constexpr int LDP = 7168, NPT = 7424;
constexpr int C_MQ = 0, C_MK = 512, C_MV = 1024, C_MO = 1536, C_FQ = 2048, C_FK = 3072, C_FV = 4096, C_GQ = 5120, C_GK = 5632, C_GV = 6144, C_GZ = 6656;
constexpr float NORM_EPS = 1e-6f, QK_SCALE = 0.08838834764831845f;
constexpr size_t MiB = 1u << 20;
constexpr size_t WS_CTL = 0, CTL_ZERO_BYTES = 1 * MiB;
constexpr size_t WL_WIN = 0, WL_WOUT = 29 * MiB, WL_WGU = 37 * MiB, WL_WDN = 81 * MiB, WL_STRIDE = 103 * MiB;
constexpr size_t WS_W = 1 * MiB;
constexpr size_t WS_H = 207 * MiB;
constexpr size_t WS_HM = WS_H, WS_HG = WS_H + 16 * MiB;
constexpr size_t WS_P = 239 * MiB;
constexpr size_t WS_GR = 351 * MiB, WS_GP = 352 * MiB;
constexpr size_t WS_CN = 353 * MiB;
constexpr size_t WS_QN = 354 * MiB, WS_KN = 362 * MiB, WS_VC = 370 * MiB;
constexpr size_t WS_HF = 378 * MiB;
constexpr size_t WS_Y = 410 * MiB;
constexpr size_t WS_PRM = 442 * MiB;
constexpr size_t WS_END = 443 * MiB;
constexpr int PRM_STRIDE = 16384, PR_MIXN = 0, PR_FFNN = 2048, PR_CONV = 4096, PR_MNORM = 10240, PR_FNORM = 10752, PR_GNORM = 11776, PR_IB = 12288, PR_FB = 12292, PR_XB = 12296, PR_ALOG = 12304, PR_DT = 12308, PR_FINAL = 2 * PRM_STRIDE;
constexpr int CW_BAR = 4096;
constexpr int RING_OFF = 0, RING_BYTES = 131072;
constexpr int LDSCTL_OFF = RING_BYTES, MISC_OFF = LDSCTL_OFF + 320;
constexpr int LDS_BYTES = 147456;
static_assert(fox::LDS_BYTES <= RING_BYTES, "fox lds");

__device__ __forceinline__ float bf2f(bf16 v) { return __uint_as_float((unsigned)v << 16); }
__device__ __forceinline__ float bflo(unsigned u) { return __uint_as_float(u << 16); }
__device__ __forceinline__ float bfhi(unsigned u) { return __uint_as_float(u & 0xffff0000u); }
__device__ __forceinline__ float wave_sum(float v) {
#pragma unroll
    for (int o = 1; o < 64; o <<= 1) v += __shfl_xor(v, o);
    return v;
}
__device__ __forceinline__ float sigmoidf_(float x) { return 1.0f / (1.0f + expf(-x)); }
__device__ __forceinline__ float softplusf_(float x) { return fmaxf(x, 0.f) + log1pf(expf(-fabsf(x))); }
__device__ __forceinline__ float logsigmoidf_(float x) { return fminf(x, 0.f) - log1pf(expf(-fabsf(x))); }
__device__ __forceinline__ float softcapf_(float x) { return 15.0f * tanhf(x * (1.0f / 15.0f)); }

__device__ __forceinline__ void transpose_item(const float* W, int ldw, int scol, bf16* WT, int Kd, int drow, int k0, LAS float* scr, int lane) {
#pragma unroll 8
    for (int i = 0; i < 32; ++i) { const int kk = 2 * i + (lane >> 5); scr[kk * 33 + (lane & 31)] = W[(size_t)(k0 + kk) * ldw + scol + (lane & 31)]; }
    LDS_WAIT(); asm volatile("" ::: "memory");
    const int c = lane & 7;
#pragma unroll
    for (int j = 0; j < 4; ++j) { const int n = (lane >> 3) + 8 * j; const LAS float* s = scr + (8 * c) * 33 + n;
        v4u o; o.x = pk2(s[0 * 33], s[1 * 33]); o.y = pk2(s[2 * 33], s[3 * 33]); o.z = pk2(s[4 * 33], s[5 * 33]); o.w = pk2(s[6 * 33], s[7 * 33]);
        *(GAS v4u*)(WT + (size_t)(drow + n) * Kd + k0 + 8 * c) = o; }
    LDS_WAIT(); asm volatile("" ::: "memory");
}
__device__ __forceinline__ void weights_phase(const float* w_in, const float* w_out, const float* w_gate, const float* w_up, const float* w_down,
                                              bf16* WIN, bf16* WOUT, bf16* WGU, bf16* WDN, LAS unsigned char* lds, int gw, int NGW, int wave, int lane, int gtid, int NGT) {
    LAS float* scr = (LAS float*)(lds + RING_OFF + wave * 16384);
    constexpr int I_A = 32 * 64, I_B = 32 * 96, I_C = 32 * 64, I_O = 32 * 64, I_G = 32 * 176, I_U = 32 * 176, I_D = 88 * 64;
    constexpr int NITEMS = I_A + I_B + I_C + I_O + I_G + I_U + I_D;
    for (int it = gw; it < NITEMS; it += NGW) {
        int r = it;
        if (r < I_A) { const int kb = r / 64, nb = r % 64; transpose_item(w_in, NIN, 32 * nb, WIN, DM, 32 * nb, 64 * kb, scr, lane); continue; } r -= I_A;
        if (r < I_B) { const int kb = r / 96, nb = r % 96; transpose_item(w_in, NIN, 2056 + 32 * nb, WIN, DM, 2048 + 32 * nb, 64 * kb, scr, lane); continue; } r -= I_B;
        if (r < I_C) { const int kb = r / 64, nb = r % 64; transpose_item(w_in, NIN, 5136 + 32 * nb, WIN, DM, 5120 + 32 * nb, 64 * kb, scr, lane); continue; } r -= I_C;
        if (r < I_O) { const int kb = r / 64, nb = r % 64; transpose_item(w_out, DM, 32 * nb, WOUT, DM, 32 * nb, 64 * kb, scr, lane); continue; } r -= I_O;
        if (r < I_G) { const int kb = r / 176, nb = r % 176; transpose_item(w_gate, DFF, 32 * nb, WGU, DM, 256 * (nb >> 2) + 32 * (nb & 3), 64 * kb, scr, lane); continue; } r -= I_G;
        if (r < I_U) { const int kb = r / 176, nb = r % 176; transpose_item(w_up, DFF, 32 * nb, WGU, DM, 256 * (nb >> 2) + 128 + 32 * (nb & 3), 64 * kb, scr, lane); continue; } r -= I_U;
        { const int kb = r / 64, nb = r % 64; transpose_item(w_down, DM, 32 * nb, WDN, DFF, 32 * nb, 64 * kb, scr, lane); }
    }
    for (int idx = gtid; idx < 256 * DM; idx += NGT) { const int r = idx / DM, k = idx % DM; float v = 0.f;
        if (r < 24) { const int sc = r < 8 ? 2048 + r : (r < 16 ? 5128 + (r - 8) : 7184 + (r - 16)); v = w_in[(size_t)k * NIN + sc]; }
        WIN[(size_t)(7168 + r) * DM + k] = (bf16)f2bf(v); }
}
__device__ __forceinline__ void rms_row_bf16(const float* xrow, const float* w, bf16* orow, int lane) {
    const f32x4* xr = (const f32x4*)xrow + lane; const f32x4* wr = (const f32x4*)w + lane;
    f32x4 v[8]; float s = 0.f;
#pragma unroll
    for (int j = 0; j < 8; ++j) { v[j] = xr[64 * j]; s += (v[j].x * v[j].x + v[j].y * v[j].y) + (v[j].z * v[j].z + v[j].w * v[j].w); }
    const float rstd = 1.0f / sqrtf(wave_sum(s) * (1.0f / DM) + NORM_EPS);
    unsigned long long* o8 = (unsigned long long*)orow + lane;
#pragma unroll
    for (int j = 0; j < 8; ++j) { const f32x4 g = wr[64 * j];
        o8[64 * j] = (unsigned long long)pk2(v[j].x * rstd * g.x, v[j].y * rstd * g.y) | ((unsigned long long)pk2(v[j].z * rstd * g.z, v[j].w * rstd * g.w) << 32); }
}
__device__ __forceinline__ void rms_row_f32(float* xrow, const float* w, int lane) {
    f32x4* xr = (f32x4*)xrow + lane; const f32x4* wr = (const f32x4*)w + lane;
    f32x4 v[8]; float s = 0.f;
#pragma unroll
    for (int j = 0; j < 8; ++j) { v[j] = xr[64 * j]; s += (v[j].x * v[j].x + v[j].y * v[j].y) + (v[j].z * v[j].z + v[j].w * v[j].w); }
    const float rstd = 1.0f / sqrtf(wave_sum(s) * (1.0f / DM) + NORM_EPS);
#pragma unroll
    for (int j = 0; j < 8; ++j) { const f32x4 g = wr[64 * j]; xr[64 * j] = (f32x4){v[j].x * rstd * g.x, v[j].y * rstd * g.y, v[j].z * rstd * g.z, v[j].w * rstd * g.w}; }
}
__device__ __forceinline__ void prep_row(int m, const bf16* P, const float* GR, float* GP, bf16* QN, bf16* KN, bf16* VC, const float* conv_w,
                                         const float* i_bias, const float* f_bias, const float* a_log, const float* dt_bias, int lane) {
    const int t = m % SEQ;
#pragma unroll
    for (int g = 0; g < 3; ++g) {
        const int ch = g * 512 + lane * 8;
        float acc[8];
#pragma unroll
        for (int i = 0; i < 8; ++i) acc[i] = 0.f;
#pragma unroll
        for (int j = 0; j < 4; ++j) {
            const int tt = t - 3 + j;
            if (tt >= 0) {
                const v4u xv = *(const v4u*)(P + (size_t)(m - 3 + j) * LDP + C_GQ + ch);
                const f32x4 w0 = *(const f32x4*)(conv_w + j * 1536 + ch), w1 = *(const f32x4*)(conv_w + j * 1536 + ch + 4);
                acc[0] += w0.x * bflo(xv.x); acc[1] += w0.y * bfhi(xv.x); acc[2] += w0.z * bflo(xv.y); acc[3] += w0.w * bfhi(xv.y);
                acc[4] += w1.x * bflo(xv.z); acc[5] += w1.y * bfhi(xv.z); acc[6] += w1.z * bflo(xv.w); acc[7] += w1.w * bfhi(xv.w);
            }
        }
        float ss = 0.f;
#pragma unroll
        for (int i = 0; i < 8; ++i) { const float v = acc[i]; acc[i] = v * sigmoidf_(v); ss += acc[i] * acc[i]; }
        if (g < 2) {
            ss += __shfl_xor(ss, 1); ss += __shfl_xor(ss, 2); ss += __shfl_xor(ss, 4); ss += __shfl_xor(ss, 8);
            const float rn = 1.0f / sqrtf(ss + NORM_EPS);
#pragma unroll
            for (int i = 0; i < 8; ++i) acc[i] *= rn;
        }
        v4u o; o.x = pk2(acc[0], acc[1]); o.y = pk2(acc[2], acc[3]); o.z = pk2(acc[4], acc[5]); o.w = pk2(acc[6], acc[7]);
        bf16* dst = (g == 0 ? QN : (g == 1 ? KN : VC)) + (size_t)m * 512 + lane * 8;
        *(v4u*)dst = o;
    }
    if (lane < 24) {
        const float raw = GR[(size_t)m * 32 + lane]; float v;
        if (lane < 4) v = softcapf_(raw + i_bias[lane]);
        else if (lane < 8) v = logsigmoidf_(softcapf_(raw + f_bias[lane - 4]));
        else if (lane < 16) v = raw;
        else if (lane < 20) v = -expf(a_log[lane - 16]) * softplusf_(raw + dt_bias[lane - 16]);
        else v = sigmoidf_(raw);
        GP[(size_t)m * 32 + lane] = v;
    }
}
__device__ __forceinline__ void fox_cumsum_unit(int bh, const float* GR, const float* fox_bias, float* CN, int lane) {
    const int b = bh >> 3, h = bh & 7; const float bias = fox_bias[h];
    float loc[64]; float run = 0.f;
#pragma unroll
    for (int i = 0; i < 64; ++i) { const int t = lane * 64 + i; run += logsigmoidf_(GR[(size_t)(b * SEQ + t) * 32 + 8 + h] + bias); loc[i] = run; }
    float incl = run;
#pragma unroll
    for (int o = 1; o < 64; o <<= 1) { const float n = __shfl_up(incl, o); if (lane >= o) incl += n; }
    const float excl = incl - run;
#pragma unroll
    for (int i = 0; i < 64; ++i) CN[(size_t)bh * SEQ + lane * 64 + i] = -(excl + loc[i]) * (1.0f / QK_SCALE);
}
__device__ __forceinline__ void mlstm_naive_unit(int unit, const bf16* P, const float* GP, float* HM, int lane) {
    const int bh = unit >> 1, eh = unit & 1, b = bh >> 2, h = bh & 3, e = eh * 64 + lane;
    float C[128];
#pragma unroll
    for (int d = 0; d < 128; ++d) C[d] = 0.f;
    float n0 = 0.f, n1 = 0.f, mst = 0.f;
    for (int t = 0; t < SEQ; ++t) {
        const size_t row = (size_t)b * SEQ + t; const bf16* pr = P + row * LDP;
        const float it = GP[row * 32 + h], lf = GP[row * 32 + 4 + h];
        const float mn = fmaxf(lf + mst, it); const float fs = expf(lf + mst - mn), is = expf(it - mn); mst = mn;
        const float iv = is * bf2f(pr[C_MV + h * 128 + e]);
        float num = 0.f;
        const v4u* kq = (const v4u*)(pr + C_MK + h * 128); const v4u* qq = (const v4u*)(pr + C_MQ + h * 128);
#pragma unroll
        for (int c = 0; c < 16; ++c) { const v4u kv = kq[c], qv = qq[c];
            const float k8[8] = {bflo(kv.x), bfhi(kv.x), bflo(kv.y), bfhi(kv.y), bflo(kv.z), bfhi(kv.z), bflo(kv.w), bfhi(kv.w)};
            const float q8[8] = {bflo(qv.x), bfhi(qv.x), bflo(qv.y), bfhi(qv.y), bflo(qv.z), bfhi(qv.z), bflo(qv.w), bfhi(qv.w)};
#pragma unroll
            for (int j = 0; j < 8; ++j) { C[8 * c + j] = fs * C[8 * c + j] + iv * (k8[j] * QK_SCALE); num += q8[j] * C[8 * c + j]; }
            if ((c & 3) == 3) __builtin_amdgcn_sched_barrier(0); }
        const float kl0 = bf2f(pr[C_MK + h * 128 + lane]) * QK_SCALE, kl1 = bf2f(pr[C_MK + h * 128 + 64 + lane]) * QK_SCALE;
        const float ql0 = bf2f(pr[C_MQ + h * 128 + lane]), ql1 = bf2f(pr[C_MQ + h * 128 + 64 + lane]);
        n0 = fs * n0 + is * kl0; n1 = fs * n1 + is * kl1;
        const float qn = wave_sum(ql0 * n0 + ql1 * n1);
        HM[row * 512 + h * 128 + e] = num / fmaxf(fabsf(qn), expf(-mst));
    }
}
__device__ __forceinline__ void gdn_naive_unit(int unit, const bf16* QN, const bf16* KN, const bf16* VC, const float* GP, float* HG, int lane) {
    const int bh = unit >> 1, eh = unit & 1, b = bh >> 2, h = bh & 3, e = eh * 64 + lane;
    float S[128];
#pragma unroll
    for (int d = 0; d < 128; ++d) S[d] = 0.f;
    for (int t = 0; t < SEQ; ++t) {
        const size_t row = (size_t)b * SEQ + t;
        const float eg = expf(GP[row * 32 + 16 + h]), beta = GP[row * 32 + 20 + h];
        const float ve = bf2f(VC[row * 512 + h * 128 + e]);
        const v4u* kq = (const v4u*)(KN + row * 512 + h * 128); const v4u* qq = (const v4u*)(QN + row * 512 + h * 128);
        float ks = 0.f;
#pragma unroll
        for (int c = 0; c < 16; ++c) { const v4u kv = kq[c];
            const float k8[8] = {bflo(kv.x), bfhi(kv.x), bflo(kv.y), bfhi(kv.y), bflo(kv.z), bfhi(kv.z), bflo(kv.w), bfhi(kv.w)};
#pragma unroll
            for (int j = 0; j < 8; ++j) ks += k8[j] * S[8 * c + j];
            if ((c & 3) == 3) __builtin_amdgcn_sched_barrier(0); }
        const float coef = beta * (ve - eg * ks);
        float o = 0.f;
#pragma unroll
        for (int c = 0; c < 16; ++c) { const v4u kv = kq[c], qv = qq[c];
            const float k8[8] = {bflo(kv.x), bfhi(kv.x), bflo(kv.y), bfhi(kv.y), bflo(kv.z), bfhi(kv.z), bflo(kv.w), bfhi(kv.w)};
            const float q8[8] = {bflo(qv.x), bfhi(qv.x), bflo(qv.y), bfhi(qv.y), bflo(qv.z), bfhi(qv.z), bflo(qv.w), bfhi(qv.w)};
#pragma unroll
            for (int j = 0; j < 8; ++j) { S[8 * c + j] = eg * S[8 * c + j] + k8[j] * coef; o += q8[j] * S[8 * c + j]; }
            if ((c & 3) == 3) __builtin_amdgcn_sched_barrier(0); }
        HG[row * 512 + h * 128 + e] = o * QK_SCALE;
    }
}
__device__ __forceinline__ void post_row(int m, const bf16* P, const float* HM, const float* HF, const float* HG, bf16* Y,
                                         const float* wm, const float* wf, const float* wg, int lane) {
    const bf16* pr = P + (size_t)m * LDP; unsigned* yr = (unsigned*)(Y + (size_t)m * DM);
#pragma unroll
    for (int h = 0; h < 4; ++h) {
        const float2 v = *(const float2*)(HM + (size_t)m * 512 + h * 128 + 2 * lane);
        const float mean = wave_sum(v.x + v.y) * (1.0f / 128.0f); const float c0 = v.x - mean, c1 = v.y - mean;
        const float rstd = 1.0f / sqrtf(wave_sum(c0 * c0 + c1 * c1) * (1.0f / 128.0f) + NORM_EPS);
        const float2 w = *(const float2*)(wm + h * 128 + 2 * lane); const unsigned go = *(const unsigned*)(pr + C_MO + h * 128 + 2 * lane);
        yr[(h * 128) / 2 + lane] = pk2(c0 * rstd * w.x * sigmoidf_(bflo(go)), c1 * rstd * w.y * sigmoidf_(bfhi(go)));
    }
#pragma unroll
    for (int h = 0; h < 8; ++h) {
        const float2 v = *(const float2*)(HF + (size_t)m * 1024 + h * 128 + 2 * lane);
        const float rstd = 1.0f / sqrtf(wave_sum(v.x * v.x + v.y * v.y) * (1.0f / 128.0f) + NORM_EPS);
        const float2 w = *(const float2*)(wf + h * 128 + 2 * lane);
        yr[(512 + h * 128) / 2 + lane] = pk2(v.x * rstd * w.x, v.y * rstd * w.y);
    }
#pragma unroll
    for (int h = 0; h < 4; ++h) {
        const float2 v = *(const float2*)(HG + (size_t)m * 512 + h * 128 + 2 * lane);
        const float rstd = 1.0f / sqrtf(wave_sum(v.x * v.x + v.y * v.y) * (1.0f / 128.0f) + NORM_EPS);
        const float2 w = *(const float2*)(wg + h * 128 + 2 * lane); const unsigned gz = *(const unsigned*)(pr + C_GZ + h * 128 + 2 * lane);
        const float z0 = bflo(gz), z1 = bfhi(gz);
        yr[(1536 + h * 128) / 2 + lane] = pk2(v.x * rstd * w.x * z0 * sigmoidf_(z0), v.y * rstd * w.y * z1 * sigmoidf_(z1));
    }
}

__device__ __forceinline__ GAS unsigned char* launder(unsigned char* p) { GAS unsigned char* g = (GAS unsigned char*)p; asm volatile("" : "+s"(g)); return g; }
__device__ __forceinline__ int tid_l() { int t = threadIdx.x; asm volatile("" : "+v"(t)); return t; }
__device__ __forceinline__ void copy_f32(const float* src, float* dst, int n, int gtid, int NGT) { for (int i = gtid; i < n; i += NGT) dst[i] = src[i]; }
struct Args { const float* in[18]; float* out; unsigned char* ws; };

template <int L>
__device__ __forceinline__ void layer_body(unsigned char* ws_, const float* xin, float* X, const XcdBarrier& bar, unsigned char* lds) {
    LAS unsigned char* ldsl = (LAS unsigned char*)lds;
#ifndef NO_PH0
    { GAS unsigned char* w = launder(ws_); const int tl = tid_l(), lane = tl & 63, gw = blockIdx.x * NWAVES + (tl >> 6), NGW = gridDim.x * NWAVES;
      const float* prm = (const float*)(w + WS_PRM) + L * PRM_STRIDE; bf16* H = (bf16*)(w + WS_H);
      for (int m = gw; m < M; m += NGW) rms_row_bf16(xin + (size_t)m * DM, prm + PR_MIXN, H + (size_t)m * DM, lane); }
#endif
    xcd_barrier(bar);
#ifndef NO_PH1
    { GAS unsigned char* w = launder(ws_);
      pg8::Gemm g{(const bf16*)(w + WS_H), (const bf16*)(w + WS_W + L * WL_STRIDE + WL_WIN), M, NPT, DM}; pg8::StaticOrder S; S.init(M, NPT, gridDim.x, blockIdx.x);
      pg8::EpiProj E{(bf16*)(w + WS_P), (float*)(w + WS_GR)};
      pg8::gemm_phase<pg8::EpiProj, pg8::StaticOrder, true, true>(ldsl + RING_OFF, g, S, E); }
#endif
    xcd_barrier(bar);
#ifndef NO_PH2
    { GAS unsigned char* w = launder(ws_); const int tl = tid_l(), lane = tl & 63, gw = blockIdx.x * NWAVES + (tl >> 6), NGW = gridDim.x * NWAVES;
      const float* prm = (const float*)(w + WS_PRM) + L * PRM_STRIDE; const float* GR = (const float*)(w + WS_GR);
      if (gw < 16) fox_cumsum_unit(gw, GR, prm + PR_XB, (float*)(w + WS_CN), lane);
      for (int m = gw; m < M; m += NGW) prep_row(m, (const bf16*)(w + WS_P), GR, (float*)(w + WS_GP), (bf16*)(w + WS_QN), (bf16*)(w + WS_KN), (bf16*)(w + WS_VC),
                                                 prm + PR_CONV, prm + PR_IB, prm + PR_FB, prm + PR_ALOG, prm + PR_DT, lane); }
#endif
    xcd_barrier(bar);
    { const int bx = blockIdx.x;
#ifndef NO_FOX
      if (bx < 128) {
        GAS unsigned char* w = launder(ws_); const bf16* P = (const bf16*)(w + WS_P); float* HF = (float*)(w + WS_HF); const float* CN = (const float*)(w + WS_CN);
        const int bh = bx >> 3, xq = bx & 7, b = bh >> 3, h = bh & 7;
        const int qb0 = xq, qb1 = 15 - xq;
        fox::BlockRef r0, r1;
        r0.Q = P + ((size_t)b * SEQ + (size_t)qb0 * 256) * LDP + C_FQ + h * 128; r0.K = P + (size_t)b * SEQ * LDP + C_FK + h * 128; r0.V = P + (size_t)b * SEQ * LDP + C_FV + h * 128;
        r0.CB = CN + (size_t)bh * SEQ; r0.O = HF + ((size_t)b * SEQ + (size_t)qb0 * 256) * 1024 + h * 128; r0.P0 = qb0 * 256;
        r1 = r0; r1.Q = P + ((size_t)b * SEQ + (size_t)qb1 * 256) * LDP + C_FQ + h * 128; r1.O = HF + ((size_t)b * SEQ + (size_t)qb1 * 256) * 1024 + h * 128; r1.P0 = qb1 * 256;
        fox::Seam S;
        fox::prime(r0, (char*)lds, S); fox::block(r0, (char*)lds, S);
        fox::prime(r1, (char*)lds, S); fox::block(r1, (char*)lds, S);
      }
#endif
#ifndef NO_ML
      if (bx >= 128 && bx < 144) { const int tl = tid_l(); if (tl < 64) { GAS unsigned char* w = launder(ws_); mlstm_naive_unit(bx - 128, (const bf16*)(w + WS_P), (const float*)(w + WS_GP), (float*)(w + WS_HM), tl & 63); } }
#endif
#ifndef NO_GDN
      if (bx >= 144 && bx < 160) { const int tl = tid_l(); if (tl < 64) { GAS unsigned char* w = launder(ws_); gdn_naive_unit(bx - 144, (const bf16*)(w + WS_QN), (const bf16*)(w + WS_KN), (const bf16*)(w + WS_VC), (const float*)(w + WS_GP), (float*)(w + WS_HG), tl & 63); } }
#endif
    }
    xcd_barrier(bar);
#ifndef NO_PH4
    { GAS unsigned char* w = launder(ws_); const int tl = tid_l(), lane = tl & 63, gw = blockIdx.x * NWAVES + (tl >> 6), NGW = gridDim.x * NWAVES;
      const float* prm = (const float*)(w + WS_PRM) + L * PRM_STRIDE;
      for (int m = gw; m < M; m += NGW) post_row(m, (const bf16*)(w + WS_P), (const float*)(w + WS_HM), (const float*)(w + WS_HF), (const float*)(w + WS_HG), (bf16*)(w + WS_Y),
                                                 prm + PR_MNORM, prm + PR_FNORM, prm + PR_GNORM, lane); }
#endif
    xcd_barrier(bar);
#ifndef NO_PH5
    { GAS unsigned char* w = launder(ws_);
      pg8::Gemm g{(const bf16*)(w + WS_Y), (const bf16*)(w + WS_W + L * WL_STRIDE + WL_WOUT), M, DM, DM}; pg8::StaticOrder S; S.init(M, DM, gridDim.x, blockIdx.x); pg8::EpiRes E{xin, X};
      pg8::gemm_phase<pg8::EpiRes, pg8::StaticOrder, true, true>(ldsl + RING_OFF, g, S, E); }
#endif
    xcd_barrier(bar);
#ifndef NO_PH6
    { GAS unsigned char* w = launder(ws_); const int tl = tid_l(), lane = tl & 63, gw = blockIdx.x * NWAVES + (tl >> 6), NGW = gridDim.x * NWAVES;
      const float* prm = (const float*)(w + WS_PRM) + L * PRM_STRIDE; bf16* H = (bf16*)(w + WS_H);
      for (int m = gw; m < M; m += NGW) rms_row_bf16(X + (size_t)m * DM, prm + PR_FFNN, H + (size_t)m * DM, lane); }
#endif
    xcd_barrier(bar);
#ifndef NO_PH7
    { GAS unsigned char* w = launder(ws_);
      pg8::Gemm g{(const bf16*)(w + WS_H), (const bf16*)(w + WS_W + L * WL_STRIDE + WL_WGU), M, 2 * DFF, DM}; pg8::StaticOrder S; S.init(M, 2 * DFF, gridDim.x, blockIdx.x); pg8::EpiSwiglu E{(bf16*)(w + WS_P)};
      pg8::gemm_phase<pg8::EpiSwiglu, pg8::StaticOrder, true, true>(ldsl + RING_OFF, g, S, E); }
#endif
    xcd_barrier(bar);
#ifndef NO_PH8
    { GAS unsigned char* w = launder(ws_);
      pg8::Gemm g{(const bf16*)(w + WS_P), (const bf16*)(w + WS_W + L * WL_STRIDE + WL_WDN), M, DM, DFF}; pg8::StaticOrder S; S.init(M, DM, gridDim.x, blockIdx.x); pg8::EpiRes E{X, X};
      pg8::gemm_phase<pg8::EpiRes, pg8::StaticOrder, true, true>(ldsl + RING_OFF, g, S, E); }
#endif
    xcd_barrier(bar);
}

__global__ void __launch_bounds__(NWAVES * 64, 2) hybrid_fwd(Args args) {
    extern __shared__ __attribute__((aligned(16))) unsigned char lds[];
    LAS unsigned char* ldsl = (LAS unsigned char*)lds;
    volatile LAS unsigned* MISC = (volatile LAS unsigned*)(ldsl + MISC_OFF);
    unsigned char* ws = args.ws;
    for (int u = threadIdx.x; u < (LDS_BYTES - LDSCTL_OFF) / 4; u += NWAVES * 64) ((LAS unsigned*)(ldsl + LDSCTL_OFF))[u] = 0u;
    __syncthreads();
    XcdBarrier bar = xcd_barrier_post((unsigned*)(ws + WS_CTL) + CW_BAR, MISC + 8);
#ifndef NO_PRO
    { const int tid = tid_l(), lane = tid & 63, wave = __builtin_amdgcn_readfirstlane(tid >> 6);
      const int gw = blockIdx.x * NWAVES + wave, NGW = gridDim.x * NWAVES, gtid = blockIdx.x * (NWAVES * 64) + tid, NGT = gridDim.x * NWAVES * 64;
#pragma unroll
      for (int l = 0; l < DEPTH; ++l) {
        unsigned char* wl = ws + WS_W + l * WL_STRIDE;
        weights_phase(args.in[2] + (size_t)l * DM * NIN, args.in[12] + (size_t)l * DM * DM, args.in[14] + (size_t)l * DM * DFF, args.in[15] + (size_t)l * DM * DFF, args.in[16] + (size_t)l * DFF * DM,
                      (bf16*)(wl + WL_WIN), (bf16*)(wl + WL_WOUT), (bf16*)(wl + WL_WGU), (bf16*)(wl + WL_WDN), ldsl, gw, NGW, wave, lane, gtid, NGT);
        float* prm = (float*)(ws + WS_PRM) + l * PRM_STRIDE;
        copy_f32(args.in[1] + l * DM, prm + PR_MIXN, DM, gtid, NGT); copy_f32(args.in[13] + l * DM, prm + PR_FFNN, DM, gtid, NGT);
        copy_f32(args.in[6] + l * 6144, prm + PR_CONV, 6144, gtid, NGT); copy_f32(args.in[9] + l * 512, prm + PR_MNORM, 512, gtid, NGT);
        copy_f32(args.in[10] + l * 1024, prm + PR_FNORM, 1024, gtid, NGT); copy_f32(args.in[11] + l * 512, prm + PR_GNORM, 512, gtid, NGT);
        copy_f32(args.in[3] + l * 4, prm + PR_IB, 4, gtid, NGT); copy_f32(args.in[4] + l * 4, prm + PR_FB, 4, gtid, NGT); copy_f32(args.in[5] + l * 8, prm + PR_XB, 8, gtid, NGT);
        copy_f32(args.in[7] + l * 4, prm + PR_ALOG, 4, gtid, NGT); copy_f32(args.in[8] + l * 4, prm + PR_DT, 4, gtid, NGT);
      }
      copy_f32(args.in[17], (float*)(ws + WS_PRM) + PR_FINAL, DM, gtid, NGT); }
#endif
    xcd_barrier(bar);
    layer_body<0>(ws, args.in[0], args.out, bar, lds);
    layer_body<1>(ws, args.out, args.out, bar, lds);
    { GAS unsigned char* w = launder(ws); const int tl = tid_l(), lane = tl & 63, gw = blockIdx.x * NWAVES + (tl >> 6), NGW = gridDim.x * NWAVES;
      const float* prm = (const float*)(w + WS_PRM) + PR_FINAL; float* X = args.out;
      for (int m = gw; m < M; m += NGW) rms_row_f32(X + (size_t)m * DM, prm, lane); }
}

extern "C" void kernel_launch(void* const* d_in, const int* in_sizes, int n_in, void* d_out, int out_size, void* d_ws, size_t ws_size, hipStream_t stream) {
    static int grid = 0;
    if (grid == 0) {
        if (n_in != 18 || in_sizes[0] != M * DM || out_size != M * DM || ws_size < WS_END) {
            fprintf(stderr, "kernel_launch: unexpected shapes: n_in %d in0 %d out %d ws %zu (need >= %zu)\n", n_in, n_in > 0 ? in_sizes[0] : -1, out_size, ws_size, (size_t)WS_END); grid = -1; return; }
        int dev = 0, cus = 0, per_cu = 0;
        if (hipGetDevice(&dev) != hipSuccess || hipDeviceGetAttribute(&cus, hipDeviceAttributeMultiprocessorCount, dev) != hipSuccess) { grid = -1; return; }
        if (hipFuncSetAttribute((const void*)hybrid_fwd, hipFuncAttributeMaxDynamicSharedMemorySize, LDS_BYTES) != hipSuccess) { fprintf(stderr, "kernel_launch: hipFuncSetAttribute failed\n"); grid = -1; return; }
        if (hipOccupancyMaxActiveBlocksPerMultiprocessor(&per_cu, (const void*)hybrid_fwd, NWAVES * 64, LDS_BYTES) != hipSuccess || per_cu < 1) {
            fprintf(stderr, "kernel_launch: occupancy query says %d blocks per CU\n", per_cu); (void)hipGetLastError(); grid = -1; return; }
        grid = cus;
        if (grid < 160 || grid % 8 != 0) { fprintf(stderr, "kernel_launch: unsupported CU count %d\n", cus); grid = -1; return; }
    }
    if (grid < 0) return;
    if (hipMemsetAsync((char*)d_ws + WS_CTL, 0, CTL_ZERO_BYTES, stream) != hipSuccess) return;
    Args a{};
    for (int i = 0; i < 18; ++i) a.in[i] = (const float*)d_in[i];
    a.out = (float*)d_out; a.ws = (unsigned char*)d_ws;
    hipLaunchKernelGGL(hybrid_fwd, dim3(grid), dim3(NWAVES * 64), LDS_BYTES, stream, a);
}
```

```cpp
#include <hip/hip_runtime.h>
#include <cstdio>
#include <cstdint>
namespace pg8 {
#define PG8_LAS __attribute__((address_space(3)))
typedef unsigned short bf16_t;
typedef short bf16x8 __attribute__((ext_vector_type(8)));
typedef float f32x4 __attribute__((ext_vector_type(4)));
typedef unsigned u32x4 __attribute__((ext_vector_type(4)));
constexpr int BM = 256, BK = 64, HALF = 128, HTB = HALF * BK * 2  , STAGE_BYTES = 8 * HTB, NXCD = 8;

__host__ __device__ __forceinline__ int lds_byte(int r, int c) { const int st = (r >> 4) * 2 + (c >> 5), rr = r & 15, cc = c & 31, ob = rr * 64 + cc * 2; return st * 1024 + (ob ^ (((ob >> 9) & 1) << 5)); }
__host__ __device__ __forceinline__ void stage_rc(int b, int& R, int& C) { const int st = b / 1024, sb = b % 1024, swz = sb ^ (((sb >> 9) & 1) << 5); R = (st >> 1) * 16 + swz / 64; C = (st & 1) * 32 + (swz % 64) / 2; }
__host__ __device__ __forceinline__ int perm32(int rho) { const int n = rho >> 4, i = rho & 15; return 8 * (i >> 2) + 4 * n + (i & 3); }

struct Unit { int pm, pn; };
struct Gemm { const bf16_t* A; const bf16_t* Bt; int M, N, K; };

struct StaticOrder {
    int nM, nN, nwg, G, c, WGM, rot;
    __host__ __device__ void init(int M, int N, int G_, int c_, int wgm = 4, int rot_ = 0) { nM = M / BM; nN = N / BM; nwg = nM * nN; G = G_; c = c_; WGM = wgm; rot = rot_; }
    __host__ __device__ bool next(int i, Unit& u) const {
        const long L = (long)i * G + c; if (L >= nwg) return false;
        int wgid = (int)L; { const int q = nwg / NXCD, r = nwg % NXCD, xcd = wgid % NXCD, off = wgid / NXCD; wgid = (xcd < r ? xcd * (q + 1) : r * (q + 1) + (xcd - r) * q) + off; }
        const int nig = WGM * nN, gid = wgid / nig, fm = gid * WGM, gsz = (nM - fm) < WGM ? (nM - fm) : WGM;
        u.pm = fm + ((wgid % nig) % gsz); u.pn = ((wgid % nig) / gsz + rot) % nN; return true;
    }
    __device__ __forceinline__ void a_ready(const Unit&) const {}
    __device__ __forceinline__ void done(const Unit&) const {}
};

__device__ __forceinline__ unsigned cvt_pk_bf16(float lo, float hi) { unsigned r; asm volatile("v_cvt_pk_bf16_f32 %0, %1, %2" : "=v"(r) : "v"(lo), "v"(hi)); return r; }
typedef float f32x2 __attribute__((ext_vector_type(2)));
__device__ __forceinline__ void row_rstd(const float* SS, int pm, PG8_LAS float* rl) {
    const int t = threadIdx.x;
    if (t < 256) { const f32x4* p = (const f32x4*)(SS + (size_t)(pm * BM + t) * 32); f32x4 s = p[0];
#pragma unroll
        for (int i = 1; i < 8; ++i) s += p[i];
        rl[t] = 1.0f / sqrtf(((s[0] + s[1]) + (s[2] + s[3])) * (1.0f / 2048.0f) + 1e-6f); }
    asm volatile("s_waitcnt lgkmcnt(0)" ::: "memory"); __builtin_amdgcn_s_barrier(); asm volatile("" ::: "memory");
}
__device__ __forceinline__ void panel_rstd4(const float* SS, int grp, PG8_LAS float* rl4) {
    int t = threadIdx.x; asm volatile("" : "+v"(t));
#pragma unroll
    for (int h = 0; h < 2; ++h) { const int r = t + 512 * h; const f32x4* p = (const f32x4*)(SS + (size_t)(grp * 1024 + r) * 32); f32x4 s = p[0];
#pragma unroll
        for (int i = 1; i < 8; ++i) s += p[i];
        rl4[r] = 1.0f / sqrtf(((s[0] + s[1]) + (s[2] + s[3])) * (1.0f / 2048.0f) + 1e-6f); }
    __syncthreads();
}
__device__ __forceinline__ PG8_LAS float* tile_rstd(int pm, PG8_LAS float* rl4) { return rl4 + (pm & 3) * 256; }
struct EpiProj {
    static constexpr bool PERM = true, AFTER_DRAIN = false;
    bf16_t* P; float* GR; const float* SS; PG8_LAS float* rl4; unsigned* gcnt; int grp;
    __device__ __forceinline__ void operator()(const f32x4 (&acc)[2][2][4][2], const Unit& u, int wr, int wc, int fr, int fq) const {
        PG8_LAS float* rl = tile_rstd(u.pm, rl4);
        const int row0 = u.pm * BM + wr * 64 + fr, rloc = wr * 64 + fr;
        if (u.pn < 28) {
            const int col0 = u.pn * BM + wc * 32 + 8 * fq;
#pragma unroll
            for (int ai = 0; ai < 2; ++ai)
#pragma unroll
                for (int m = 0; m < 4; ++m) { bf16_t* rowp = P + (size_t)(row0 + ai * HALF + m * 16) * 7168 + col0; const float rs = rl[rloc + ai * HALF + m * 16];
#pragma unroll
                    for (int bj = 0; bj < 2; ++bj) { const f32x4 v0 = acc[ai][bj][m][0] * rs, v1 = acc[ai][bj][m][1] * rs;
                        u32x4 w; w.x = cvt_pk_bf16(v0[0], v0[1]); w.y = cvt_pk_bf16(v0[2], v0[3]); w.z = cvt_pk_bf16(v1[0], v1[1]); w.w = cvt_pk_bf16(v1[2], v1[3]);
                        *(u32x4*)(rowp + bj * HALF) = w; } }
        } else if (wc == 0) {
#pragma unroll
            for (int ai = 0; ai < 2; ++ai)
#pragma unroll
                for (int m = 0; m < 4; ++m) { float* g = GR + (size_t)(row0 + ai * HALF + m * 16) * 32 + 8 * fq; const float rs = rl[rloc + ai * HALF + m * 16];
                    *(f32x4*)g = acc[ai][0][m][0] * rs; *(f32x4*)(g + 4) = acc[ai][0][m][1] * rs; }
        }
        if (u.pn == 28) {
            asm volatile("s_waitcnt vmcnt(0)" ::: "memory"); __syncthreads();
            if (threadIdx.x == 0) { __builtin_amdgcn_fence(__ATOMIC_RELEASE, "agent"); asm volatile("s_waitcnt vmcnt(0)" ::: "memory"); (void)__hip_atomic_fetch_add(gcnt, 1u, __ATOMIC_RELAXED, __HIP_MEMORY_SCOPE_AGENT); } }
    }
};
template <bool BASE_F32>
struct EpiRes {
    static constexpr bool PERM = true, AFTER_DRAIN = false;
    const void* base; bf16_t* XB; float* SS;
    __device__ __forceinline__ void operator()(const f32x4 (&acc)[2][2][4][2], const Unit& u, int wr, int wc, int fr, int fq) const {
        const int row0 = u.pm * BM + wr * 64 + fr, col0 = u.pn * BM + wc * 32 + 8 * fq;
#pragma unroll
        for (int ai = 0; ai < 2; ++ai)
#pragma unroll
            for (int m = 0; m < 4; ++m) { const int row = row0 + ai * HALF + m * 16; const size_t off = (size_t)row * 2048 + col0; float ss = 0.f;
#pragma unroll
                for (int bj = 0; bj < 2; ++bj) { f32x4 b0, b1;
                    if constexpr (BASE_F32) { b0 = *(const f32x4*)((const float*)base + off + bj * HALF); b1 = *(const f32x4*)((const float*)base + off + bj * HALF + 4); }
                    else { const u32x4 bw = *(const u32x4*)((const bf16_t*)base + off + bj * HALF);
                        b0 = (f32x4){__uint_as_float(bw.x << 16), __uint_as_float(bw.x & 0xffff0000u), __uint_as_float(bw.y << 16), __uint_as_float(bw.y & 0xffff0000u)};
                        b1 = (f32x4){__uint_as_float(bw.z << 16), __uint_as_float(bw.z & 0xffff0000u), __uint_as_float(bw.w << 16), __uint_as_float(bw.w & 0xffff0000u)}; }
                    const f32x4 x0 = b0 + acc[ai][bj][m][0], x1 = b1 + acc[ai][bj][m][1];
                    ss += (x0[0] * x0[0] + x0[1] * x0[1]) + (x0[2] * x0[2] + x0[3] * x0[3]) + (x1[0] * x1[0] + x1[1] * x1[1]) + (x1[2] * x1[2] + x1[3] * x1[3]);
                    u32x4 hw; hw.x = cvt_pk_bf16(x0[0], x0[1]); hw.y = cvt_pk_bf16(x0[2], x0[3]); hw.z = cvt_pk_bf16(x1[0], x1[1]); hw.w = cvt_pk_bf16(x1[2], x1[3]);
                    *(u32x4*)(XB + off + bj * HALF) = hw; }
                ss += __shfl_xor(ss, 16); ss += __shfl_xor(ss, 32); if (fq == 0) SS[(size_t)row * 32 + u.pn * 4 + wc] = ss;
                asm volatile("" ::: "memory"); }
    }
};
struct EpiFinal {
    static constexpr bool PERM = true, AFTER_DRAIN = false;
    const bf16_t* base; float* out; const float* wf; float* SS; unsigned* cnt; unsigned* tmo; PG8_LAS float* rl;
    __device__ __forceinline__ void operator()(const f32x4 (&acc_)[2][2][4][2], const Unit& u, int wr, int wc, int fr, int fq) const {
        f32x4 (&acc)[2][2][4][2] = const_cast<f32x4 (&)[2][2][4][2]>(acc_);
        const int row0 = u.pm * BM + wr * 64 + fr, col0 = u.pn * BM + wc * 32 + 8 * fq, rloc = wr * 64 + fr;
#pragma unroll
        for (int ai = 0; ai < 2; ++ai)
#pragma unroll
            for (int m = 0; m < 4; ++m) { const int row = row0 + ai * HALF + m * 16; const size_t off = (size_t)row * 2048 + col0; float ss = 0.f;
#pragma unroll
                for (int bj = 0; bj < 2; ++bj) { const u32x4 bw = *(const u32x4*)(base + off + bj * HALF);
                    const f32x4 b0 = (f32x4){__uint_as_float(bw.x << 16), __uint_as_float(bw.x & 0xffff0000u), __uint_as_float(bw.y << 16), __uint_as_float(bw.y & 0xffff0000u)};
                    const f32x4 b1 = (f32x4){__uint_as_float(bw.z << 16), __uint_as_float(bw.z & 0xffff0000u), __uint_as_float(bw.w << 16), __uint_as_float(bw.w & 0xffff0000u)};
                    const f32x4 x0 = b0 + acc[ai][bj][m][0], x1 = b1 + acc[ai][bj][m][1];
                    acc[ai][bj][m][0] = x0; acc[ai][bj][m][1] = x1;
                    ss += (x0[0] * x0[0] + x0[1] * x0[1]) + (x0[2] * x0[2] + x0[3] * x0[3]) + (x1[0] * x1[0] + x1[1] * x1[1]) + (x1[2] * x1[2] + x1[3] * x1[3]); }
                ss += __shfl_xor(ss, 16); ss += __shfl_xor(ss, 32); if (fq == 0) SS[(size_t)row * 32 + u.pn * 4 + wc] = ss;
                asm volatile("" ::: "memory"); }
        asm volatile("s_waitcnt vmcnt(0)" ::: "memory");
        __syncthreads();
        if (threadIdx.x == 0) {
            __builtin_amdgcn_fence(__ATOMIC_RELEASE, "agent"); asm volatile("s_waitcnt vmcnt(0)" ::: "memory");
            (void)__hip_atomic_fetch_add(&cnt[u.pm * 64], 1u, __ATOMIC_RELAXED, __HIP_MEMORY_SCOPE_AGENT);
            unsigned sp = 0;
            while (__hip_atomic_load(&cnt[u.pm * 64], __ATOMIC_RELAXED, __HIP_MEMORY_SCOPE_AGENT) < 8u) { __builtin_amdgcn_s_sleep(1);
                if ((++sp & 255u) == 0u) { if (__hip_atomic_load(tmo, __ATOMIC_RELAXED, __HIP_MEMORY_SCOPE_AGENT)) break; if (sp > (1u << 18)) { atomicAdd(tmo, 1u); break; } } }
            __builtin_amdgcn_fence(__ATOMIC_ACQUIRE, "agent"); asm volatile("s_waitcnt vmcnt(0)" ::: "memory");
        }
        __syncthreads();
        row_rstd(SS, u.pm, rl);
        f32x4 w[2][2];
#pragma unroll
        for (int bj = 0; bj < 2; ++bj) { w[bj][0] = *(const f32x4*)(wf + col0 + bj * HALF); w[bj][1] = *(const f32x4*)(wf + col0 + bj * HALF + 4); }
#pragma unroll
        for (int ai = 0; ai < 2; ++ai)
#pragma unroll
            for (int m = 0; m < 4; ++m) { const int row = row0 + ai * HALF + m * 16; const size_t off = (size_t)row * 2048 + col0; const float rs = rl[rloc + ai * HALF + m * 16];
#pragma unroll
                for (int bj = 0; bj < 2; ++bj) { *(f32x4*)(out + off + bj * HALF) = acc[ai][bj][m][0] * rs * w[bj][0]; *(f32x4*)(out + off + bj * HALF + 4) = acc[ai][bj][m][1] * rs * w[bj][1]; } }
    }
};
struct EpiSwiglu {
    static constexpr bool PERM = true, AFTER_DRAIN = false;
    bf16_t* O; const float* SS; PG8_LAS float* rl4; int grp;
    __device__ __forceinline__ void operator()(const f32x4 (&acc)[2][2][4][2], const Unit& u, int wr, int wc, int fr, int fq) const {
        PG8_LAS float* rl = tile_rstd(u.pm, rl4);
        const int row0 = u.pm * BM + wr * 64 + fr, col0 = u.pn * HALF + wc * 32 + 8 * fq, rloc = wr * 64 + fr;
#pragma unroll
        for (int ai = 0; ai < 2; ++ai)
#pragma unroll
            for (int m = 0; m < 4; ++m) { bf16_t* rowp = O + (size_t)(row0 + ai * HALF + m * 16) * 5632 + col0; const float rs = rl[rloc + ai * HALF + m * 16];
                float r[8];
#pragma unroll
                for (int n = 0; n < 2; ++n)
#pragma unroll
                    for (int j = 0; j < 4; ++j) { const float g = acc[ai][0][m][n][j] * rs, up = acc[ai][1][m][n][j] * rs;
                        r[n * 4 + j] = g * __builtin_amdgcn_rcpf(1.0f + __expf(-g)) * up; }
                u32x4 w; w.x = cvt_pk_bf16(r[0], r[1]); w.y = cvt_pk_bf16(r[2], r[3]); w.z = cvt_pk_bf16(r[4], r[5]); w.w = cvt_pk_bf16(r[6], r[7]);
                *(u32x4*)rowp = w; }
    }
};

template <class Epi, class Sched, bool ALIGN_EPI = false, bool SP2 = false>
__device__ __forceinline__ void gemm_phase(PG8_LAS unsigned char* lds, const Gemm g, const Sched& S, const Epi& E) {
    int tid_ = threadIdx.x; asm volatile("" : "+v"(tid_));
    const int tid = tid_, wid = __builtin_amdgcn_readfirstlane(tid >> 6), lane = tid & 63, wr = wid >> 2, wc = wid & 3, fr = lane & 15, fq = lane >> 4;
    const int K = g.K, nt = K / BK;
    unsigned voffA[2], voffB[2];
#pragma unroll
    for (int i = 0; i < 2; ++i) { int R, C; stage_rc(tid * 16 + i * 8192, R, C); const int Rb = Epi::PERM ? ((R & ~31) + perm32(R & 31)) : R;
        voffA[i] = (unsigned)(R * K + C) * 2u; voffB[i] = (unsigned)(Rb * K + C) * 2u; }
    const size_t kstep = (size_t)(BK * 2);
    const size_t hstep = (size_t)HALF * K * 2;
    const size_t tstep = 2 * hstep;
    const unsigned ldsw = (unsigned)wid * 1024u;
    const int aoff = lds_byte(wr * 64 + fr, fq * 8), boff = lds_byte(wc * 32 + fr, fq * 8);
#define PG8_SA(b, h) (((b) * 2 + (h)) * HTB)
#define PG8_SB(b, h) ((4 + (b) * 2 + (h)) * HTB)
#define PG8_STAGE(bufoff, gbase, voff) do { _Pragma("unroll") for (int _i = 0; _i < 2; ++_i) \
        __builtin_amdgcn_global_load_lds((const unsigned*)((const char*)(gbase) + (voff)[_i]), (PG8_LAS unsigned*)(lds + (bufoff) + ldsw + _i * 8192), 16, 0, 0); } while (0)
#define PG8_LDA(dst, b, h) do { _Pragma("unroll") for (int m = 0; m < 4; ++m) _Pragma("unroll") for (int k = 0; k < 2; ++k) dst[m][k] = *(const PG8_LAS bf16x8*)(lds + PG8_SA(b, h) + aoff + m * 2048 + k * 1024); } while (0)
#define PG8_LDB(dst, b, h) do { _Pragma("unroll") for (int n = 0; n < 2; ++n) _Pragma("unroll") for (int k = 0; k < 2; ++k) dst[n][k] = *(const PG8_LAS bf16x8*)(lds + PG8_SB(b, h) + boff + n * 2048 + k * 1024); } while (0)
#define PG8_MMA(ai, bj, At, Bt) do { __builtin_amdgcn_s_setprio(1); _Pragma("unroll") for (int m = 0; m < 4; ++m) _Pragma("unroll") for (int n = 0; n < 2; ++n) _Pragma("unroll") for (int k = 0; k < 2; ++k) \
        acc[ai][bj][m][n] = __builtin_amdgcn_mfma_f32_16x16x32_bf16(Bt[n][k], At[m][k], acc[ai][bj][m][n], 0, 0, 0); __builtin_amdgcn_s_setprio(0); } while (0)
#define PG8_WAIT_V(n) asm volatile("s_waitcnt vmcnt(" #n ")" ::: "memory")
#define PG8_WAIT_L(n) asm volatile("s_waitcnt lgkmcnt(" #n ")" ::: "memory")
#define PG8_BAR __builtin_amdgcn_s_barrier()
#define PG8_SCHED __builtin_amdgcn_sched_barrier(0)
    Unit cur, nxt; int ui = 0;
    if (!S.next(0, cur)) return;
    f32x4 acc[2][2][4][2];
#pragma unroll
    for (int a = 0; a < 2; ++a)
#pragma unroll
        for (int b = 0; b < 2; ++b)
#pragma unroll
            for (int m = 0; m < 4; ++m)
#pragma unroll
                for (int n = 0; n < 2; ++n) acc[a][b][m][n] = (f32x4){0.f, 0.f, 0.f, 0.f};
    bf16x8 At[4][2], B0[2][2], B1[2][2];
    const char* cA = (const char*)g.A + (size_t)cur.pm * tstep; const char* cB = (const char*)g.Bt + (size_t)cur.pn * tstep;
    S.a_ready(cur);
    if constexpr (SP2) {
        PG8_STAGE(PG8_SB(0, 0), cB, voffB); PG8_STAGE(PG8_SB(0, 1), cB + hstep, voffB); PG8_STAGE(PG8_SA(0, 0), cA, voffA); PG8_STAGE(PG8_SA(0, 1), cA + hstep, voffA);
        if (wr == 1) PG8_BAR;
        PG8_WAIT_V(2); PG8_BAR;
        PG8_STAGE(PG8_SB(1, 0), cB + kstep, voffB); PG8_STAGE(PG8_SA(1, 0), cA + kstep, voffA); PG8_STAGE(PG8_SB(1, 1), cB + hstep + kstep, voffB);
        PG8_WAIT_V(6); PG8_BAR;
    } else {
        PG8_STAGE(PG8_SB(0, 0), cB, voffB); PG8_STAGE(PG8_SA(0, 0), cA, voffA); PG8_STAGE(PG8_SB(0, 1), cB + hstep, voffB); PG8_STAGE(PG8_SA(0, 1), cA + hstep, voffA);
        if (wr == 1) PG8_BAR;
        PG8_WAIT_V(4); PG8_BAR;
        PG8_STAGE(PG8_SB(1, 0), cB + kstep, voffB); PG8_STAGE(PG8_SA(1, 0), cA + kstep, voffA); PG8_STAGE(PG8_SB(1, 1), cB + hstep + kstep, voffB);
        PG8_WAIT_V(6); PG8_BAR;
    }
    for (;;) {
        const bool has_next = S.next(ui + 1, nxt);
        const char* nA = has_next ? (const char*)g.A + (size_t)nxt.pm * tstep : cA; const char* nB = has_next ? (const char*)g.Bt + (size_t)nxt.pn * tstep : cB;
        for (int t = 0; t < nt; t += 2) {
            const bool last = (t == nt - 2);
            const char* a1 = cA + (size_t)(t + 1) * kstep;
            const char* a2 = last ? nA : cA + (size_t)(t + 2) * kstep; const char* b2 = last ? nB : cB + (size_t)(t + 2) * kstep;
            const char* a3 = a2 + kstep; const char* b3 = b2 + kstep;
            if (last && has_next) S.a_ready(nxt);
            if constexpr (SP2) {
            PG8_LDB(B0, 0, 0); PG8_LDB(B1, 0, 1); PG8_SCHED; PG8_LDA(At, 0, 0); PG8_STAGE(PG8_SA(1, 1), a1 + hstep, voffA);
            PG8_WAIT_V(8); PG8_WAIT_L(0); PG8_BAR; PG8_MMA(0, 0, At, B0); PG8_MMA(0, 1, At, B1); PG8_BAR; PG8_SCHED;
            PG8_LDA(At, 0, 1); PG8_STAGE(PG8_SB(0, 0), b2, voffB); PG8_STAGE(PG8_SB(0, 1), b2 + hstep, voffB); PG8_STAGE(PG8_SA(0, 0), a2, voffA);
            PG8_WAIT_V(8); PG8_WAIT_L(0); PG8_BAR; PG8_MMA(1, 0, At, B0); PG8_MMA(1, 1, At, B1); PG8_BAR; PG8_SCHED;
            PG8_LDB(B0, 1, 0); PG8_LDB(B1, 1, 1); PG8_SCHED; PG8_LDA(At, 1, 0); PG8_STAGE(PG8_SA(0, 1), a2 + hstep, voffA);
            PG8_WAIT_V(8); PG8_WAIT_L(0); PG8_BAR; PG8_MMA(0, 0, At, B0); PG8_MMA(0, 1, At, B1); PG8_BAR; PG8_SCHED;
            PG8_LDA(At, 1, 1); PG8_STAGE(PG8_SB(1, 0), b3, voffB); PG8_STAGE(PG8_SB(1, 1), b3 + hstep, voffB); PG8_STAGE(PG8_SA(1, 0), a3, voffA);
            PG8_WAIT_V(8); PG8_WAIT_L(0); PG8_BAR; PG8_MMA(1, 0, At, B0); PG8_MMA(1, 1, At, B1); PG8_BAR; PG8_SCHED;
            } else {
            PG8_LDB(B0, 0, 0); PG8_SCHED; PG8_LDA(At, 0, 0); PG8_STAGE(PG8_SA(1, 1), a1 + hstep, voffA);
            PG8_WAIT_L(8); PG8_BAR; PG8_WAIT_L(0); PG8_MMA(0, 0, At, B0); PG8_BAR; PG8_SCHED;
            PG8_LDB(B1, 0, 1); PG8_STAGE(PG8_SB(0, 0), b2, voffB);
            PG8_BAR; PG8_WAIT_L(0); PG8_MMA(0, 1, At, B1); PG8_BAR;
            PG8_LDA(At, 0, 1); PG8_STAGE(PG8_SA(0, 0), a2, voffA);
            PG8_BAR; PG8_WAIT_L(0); PG8_MMA(1, 0, At, B0); PG8_BAR; PG8_SCHED;
            PG8_STAGE(PG8_SB(0, 1), b2 + hstep, voffB);
            PG8_WAIT_V(6); PG8_BAR; PG8_MMA(1, 1, At, B1); PG8_BAR;
            PG8_LDB(B0, 1, 0); PG8_SCHED; PG8_LDA(At, 1, 0); PG8_STAGE(PG8_SA(0, 1), a2 + hstep, voffA);
            PG8_WAIT_L(8); PG8_BAR; PG8_WAIT_L(0); PG8_MMA(0, 0, At, B0); PG8_BAR; PG8_SCHED;
            PG8_LDB(B1, 1, 1); PG8_STAGE(PG8_SB(1, 0), b3, voffB);
            PG8_BAR; PG8_WAIT_L(0); PG8_MMA(0, 1, At, B1); PG8_BAR;
            PG8_LDA(At, 1, 1); PG8_STAGE(PG8_SA(1, 0), a3, voffA);
            PG8_BAR; PG8_WAIT_L(0); PG8_MMA(1, 0, At, B0); PG8_BAR; PG8_SCHED;
            PG8_STAGE(PG8_SB(1, 1), b3 + hstep, voffB);
            PG8_WAIT_V(6); PG8_BAR; PG8_MMA(1, 1, At, B1); PG8_BAR;
            }
        }
        if constexpr (ALIGN_EPI) { if (wr == 0) PG8_BAR; }
        if constexpr (!Epi::AFTER_DRAIN) { E(acc, cur, wr, wc, fr, fq); S.done(cur); }
        if (!has_next) break;
#pragma unroll
        for (int a = 0; a < 2; ++a)
#pragma unroll
            for (int b = 0; b < 2; ++b)
#pragma unroll
                for (int m = 0; m < 4; ++m)
#pragma unroll
                    for (int n = 0; n < 2; ++n) acc[a][b][m][n] = (f32x4){0.f, 0.f, 0.f, 0.f};
        cur = nxt; cA = nA; cB = nB; ++ui;
        if constexpr (ALIGN_EPI) { if (wr == 1) PG8_BAR; }
    }
    PG8_WAIT_V(0);
    if constexpr (!ALIGN_EPI) { if (wr == 0) PG8_BAR; }
    PG8_BAR;
    if constexpr (Epi::AFTER_DRAIN) { E.fused(acc, cur, wr, wc, fr, fq, lds, wid, lane); S.done(cur); }
#undef PG8_SA
#undef PG8_SB
#undef PG8_STAGE
#undef PG8_LDA
#undef PG8_LDB
#undef PG8_MMA
#undef PG8_WAIT_V
#undef PG8_WAIT_L
#undef PG8_BAR
#undef PG8_SCHED
}
}
namespace fox {
typedef unsigned short bf16;
typedef short bf16x8 __attribute__((ext_vector_type(8)));
typedef short s16x4 __attribute__((ext_vector_type(4)));
typedef float f32x16 __attribute__((ext_vector_type(16)));
typedef float f32x4 __attribute__((ext_vector_type(4)));
typedef unsigned u32x4 __attribute__((ext_vector_type(4)));
constexpr int D = 128, LDQ = 7168;
constexpr float SCALE = 0.08838834764831845f, THR = 8.f;
constexpr int NW = 8, QBLK = 32, KVBLK = 64, QB = NW * QBLK;
constexpr int SHM_V = KVBLK * D * 2, SHM_K = KVBLK * D * 2;
constexpr int OFF_WS = 2 * SHM_V + 2 * SHM_K, OFF_B = OFF_WS + NW * 64 * 4, OFF_Q = OFF_B + 2 * 256, LDS_BYTES = OFF_Q + NW * 8 * 1024;
#define KSWZ(row, colB) ((row) * 256 + ((colB) ^ (((row) & 7) << 4)))
#define SBAR() __builtin_amdgcn_sched_barrier(0)
__device__ __forceinline__ int v_st(int k, int c) { const int kk = (k & ~0xC) | ((k & 4) << 1) | ((k & 8) >> 1); return ((kk >> 3) * 4 + (c >> 5)) * 512 + ((kk & 7) * 32 + (c & 31)) * 2; }
__device__ __forceinline__ int v_rd_base(int lane) { return ((lane & 3) << 3) | (((lane >> 2) & 3) << 6) | (((lane >> 4) & 1) << 5) | (((lane >> 5) & 1) << 8); }
constexpr int v_rd_off(int d0, int ks, int half) { return d0 * 512 + ks * 4096 + half * 2048; }
__device__ __forceinline__ int crow(int r, int hi) { return (r & 3) + 8 * (r >> 2) + 4 * hi; }
__device__ __forceinline__ unsigned cvtpk(float lo, float hi) { unsigned r; asm volatile("v_cvt_pk_bf16_f32 %0, %1, %2" : "=v"(r) : "v"(lo), "v"(hi)); return r; }
__device__ __forceinline__ bf16x8 load8(const bf16* p) { return *reinterpret_cast<const bf16x8*>(p); }
__device__ __forceinline__ void mask_tile(f32x16& p0, f32x16& p1, int dq) {
    const float NEG = -__builtin_inff();
#pragma unroll
    for (int r = 0; r < 16; ++r) { const int c = (r & 3) + 8 * (r >> 2);
        if (dq - c < 0) p0[r] = NEG;
        if (dq - c - 32 < 0) p1[r] = NEG; }
}
__device__ __forceinline__ void partialSM(f32x16& p0, f32x16& p1, float& m_reg, float& mn, float& alpha) {
    float pmax = p0[0];
#pragma unroll
    for (int r = 1; r < 16; ++r) pmax = fmaxf(pmax, p0[r]);
#pragma unroll
    for (int r = 0; r < 16; ++r) pmax = fmaxf(pmax, p1[r]);
    { auto rr = __builtin_amdgcn_permlane32_swap(__float_as_uint(pmax), __float_as_uint(pmax), false, false);
      pmax = fmaxf(__uint_as_float(rr[0]), __uint_as_float(rr[1])); }
    constexpr float C2 = 1.4426950408889634f * SCALE;
    if (__builtin_expect(__all((pmax - m_reg) * SCALE <= THR), 1)) { mn = m_reg; alpha = 1.f; }
    else { mn = fmaxf(m_reg, pmax); alpha = __builtin_amdgcn_exp2f((m_reg - mn) * C2); m_reg = mn; }
    const float mnL = -mn * C2;
#pragma unroll
    for (int r = 0; r < 16; ++r) p0[r] = fmaf(p0[r], C2, mnL);
#pragma unroll
    for (int r = 0; r < 16; ++r) p1[r] = fmaf(p1[r], C2, mnL);
#pragma unroll
    for (int r = 0; r < 16; ++r) p0[r] = __builtin_amdgcn_exp2f(p0[r]);
}
__device__ __forceinline__ void finishSM(f32x16& p0, f32x16& p1, float alpha, float& l_reg, bf16x8& pa0, bf16x8& pa1, bf16x8& pa2, bf16x8& pa3) {
#pragma unroll
    for (int r = 0; r < 16; ++r) p1[r] = __builtin_amdgcn_exp2f(p1[r]);
    float ps = 0;
#pragma unroll
    for (int r = 0; r < 16; ++r) ps += p0[r];
#pragma unroll
    for (int r = 0; r < 16; ++r) ps += p1[r];
    { auto rr = __builtin_amdgcn_permlane32_swap(__float_as_uint(ps), __float_as_uint(ps), false, false);
      ps = __uint_as_float(rr[0]) + __uint_as_float(rr[1]); }
    l_reg = l_reg * alpha + ps;
#define PK4(P, B_, OUT) do { unsigned a0 = cvtpk(P[B_+0], P[B_+1]), a1 = cvtpk(P[B_+2], P[B_+3]);                          \
        unsigned b0 = cvtpk(P[B_+4], P[B_+5]), b1 = cvtpk(P[B_+6], P[B_+7]);                                             \
        auto r0 = __builtin_amdgcn_permlane32_swap(a0, b0, false, false); auto r1 = __builtin_amdgcn_permlane32_swap(a1, b1, false, false); \
        u32x4 w = {r0[0], r1[0], r0[1], r1[1]}; OUT = *reinterpret_cast<bf16x8*>(&w); } while (0)
    PK4(p0, 0, pa0); PK4(p0, 8, pa1); PK4(p1, 0, pa2); PK4(p1, 8, pa3);
#undef PK4
}
__device__ __forceinline__ void weightsM(f32x16& p0, f32x16& p1, const char* bbuf, float m2row, int hi, bool needmask, int dq) {
    const f32x4* bl = reinterpret_cast<const f32x4*>(bbuf) + hi; const float NEG = -__builtin_inff();
    asm volatile("" : "+v"(m2row) : "v"(p0[15]), "v"(p1[15]));
#pragma unroll
    for (int g = 0; g < 4; ++g) { const f32x4 a = bl[2 * g], b = bl[8 + 2 * g];
#pragma unroll
        for (int j = 0; j < 4; ++j) { const int c = j + 8 * g; float e0 = a[j] - m2row, e1 = b[j] - m2row;
            if (needmask) { if (dq - c < 0) e0 = NEG; if (dq - c - 32 < 0) e1 = NEG; }
            p0[4 * g + j] *= SCALE * __builtin_amdgcn_exp2f(e0); p1[4 * g + j] *= SCALE * __builtin_amdgcn_exp2f(e1); }
        SBAR(); }
}
__device__ __forceinline__ void finishM(f32x16& p0, f32x16& p1, float& l_reg, bf16x8& pa0, bf16x8& pa1, bf16x8& pa2, bf16x8& pa3) {
    float ps = 0;
#pragma unroll
    for (int r = 0; r < 16; ++r) ps += p0[r];
#pragma unroll
    for (int r = 0; r < 16; ++r) ps += p1[r];
    { auto rr = __builtin_amdgcn_permlane32_swap(__float_as_uint(ps), __float_as_uint(ps), false, false);
      ps = __uint_as_float(rr[0]) + __uint_as_float(rr[1]); }
    l_reg += ps;
#define PK4(P, B_, OUT) do { unsigned a0 = cvtpk(P[B_+0], P[B_+1]), a1 = cvtpk(P[B_+2], P[B_+3]);                          \
        unsigned b0 = cvtpk(P[B_+4], P[B_+5]), b1 = cvtpk(P[B_+6], P[B_+7]);                                             \
        auto r0 = __builtin_amdgcn_permlane32_swap(a0, b0, false, false); auto r1 = __builtin_amdgcn_permlane32_swap(a1, b1, false, false); \
        u32x4 w = {r0[0], r1[0], r0[1], r1[1]}; OUT = *reinterpret_cast<bf16x8*>(&w); } while (0)
    PK4(p0, 0, pa0); PK4(p0, 8, pa1); PK4(p1, 0, pa2); PK4(p1, 8, pa3);
#undef PK4
}
template <int KB, bool MM>
__device__ __forceinline__ void qkt(f32x16& p0, f32x16& p1, const char* K_lds, const char* B_lds, int r32, int hi, const bf16x8* qr, const char* qlds) {
    if constexpr (MM) { p0 = f32x16{}; p1 = f32x16{}; }
    else { const f32x4* bl = reinterpret_cast<const f32x4*>(B_lds + KB * 256) + hi;
#pragma unroll
      for (int g = 0; g < 4; ++g) { const f32x4 a = bl[2 * g], b = bl[8 + 2 * g];
          p0[4 * g + 0] = a[0]; p0[4 * g + 1] = a[1]; p0[4 * g + 2] = a[2]; p0[4 * g + 3] = a[3];
          p1[4 * g + 0] = b[0]; p1[4 * g + 1] = b[1]; p1[4 * g + 2] = b[2]; p1[4 * g + 3] = b[3]; } }
    const char* kb[4];
#pragma unroll
    for (int dd = 0; dd < 4; ++dd) kb[dd] = K_lds + KB * SHM_K + KSWZ(r32, (dd * 16 + hi * 8) * 2);
#pragma unroll
    for (int d0 = 0; d0 < 8; ++d0) { const char* a = kb[d0 & 3] + (d0 >> 2) * 128;
        bf16x8 b0 = *reinterpret_cast<const bf16x8*>(a);
        bf16x8 b1 = *reinterpret_cast<const bf16x8*>(a + 32 * 256);
        bf16x8 qf; if constexpr (MM) qf = *reinterpret_cast<const bf16x8*>(qlds + d0 * 1024); else qf = qr[d0];
        p0 = __builtin_amdgcn_mfma_f32_32x32x16_bf16(b0, qf, p0, 0, 0, 0);
        p1 = __builtin_amdgcn_mfma_f32_32x32x16_bf16(b1, qf, p1, 0, 0, 0); }
}
template <int VB>
__device__ __forceinline__ void pv_tile(f32x16* o, int vb0, bf16x8 pa0, bf16x8 pa1, bf16x8 pa2, bf16x8 pa3) {
#define TRRD(dst, off) asm volatile("ds_read_b64_tr_b16 %0, %1 offset:%2" : "=&v"(dst) : "v"(vb0), "i"(off) : "memory")
#define PV_D0(d0) do { s16x4 l0, l1, l2, l3, h0, h1, h2, h3; constexpr int b_ = VB * SHM_V + v_rd_off(d0, 0, 0); \
        TRRD(l0, b_); TRRD(h0, b_ + 2048); TRRD(l1, b_ + 4096); TRRD(h1, b_ + 6144); TRRD(l2, b_ + 8192); TRRD(h2, b_ + 10240); TRRD(l3, b_ + 12288); TRRD(h3, b_ + 14336); \
        asm volatile("s_waitcnt lgkmcnt(0)" ::: "memory"); SBAR(); \
        o[d0] = __builtin_amdgcn_mfma_f32_32x32x16_bf16(pa0, (bf16x8){l0[0], l0[1], l0[2], l0[3], h0[0], h0[1], h0[2], h0[3]}, o[d0], 0, 0, 0);   \
        o[d0] = __builtin_amdgcn_mfma_f32_32x32x16_bf16(pa1, (bf16x8){l1[0], l1[1], l1[2], l1[3], h1[0], h1[1], h1[2], h1[3]}, o[d0], 0, 0, 0);   \
        o[d0] = __builtin_amdgcn_mfma_f32_32x32x16_bf16(pa2, (bf16x8){l2[0], l2[1], l2[2], l2[3], h2[0], h2[1], h2[2], h2[3]}, o[d0], 0, 0, 0);   \
        o[d0] = __builtin_amdgcn_mfma_f32_32x32x16_bf16(pa3, (bf16x8){l3[0], l3[1], l3[2], l3[3], h3[0], h3[1], h3[2], h3[3]}, o[d0], 0, 0, 0); } while (0)
    PV_D0(0); PV_D0(1); PV_D0(2); PV_D0(3);
#undef PV_D0
#undef TRRD
}
struct BlockRef { const bf16* K; const float* CB; bf16* Y; const float* NW; int P0; int t0, nt; float* PO; float* ST; };
template <bool MM> struct Delta { static constexpr int DQ = MM ? -512 : -1024, DV = MM ? 512 : 1024, DG = 1024; };
struct Seam { bf16x8 qr[8]; bf16x8 st_v0, st_v1, st_k0, st_k1; };
#define ROW(p, k0, rr) ((p) + (size_t)((k0) + (rr)) * LDQ + sc)
#define VMW() asm volatile("s_waitcnt vmcnt(0)" ::: "memory")
#define VMWN(n) asm volatile("s_waitcnt vmcnt(%0)" :: "i"(n) : "memory")
#define SLOAD_H(Kp, Vp, k0) do { S.st_v0 = load8(ROW(Vp, k0, sr)); S.st_v1 = load8(ROW(Vp, k0, 32 + sr));              \
                         S.st_k0 = load8(ROW(Kp, k0, sr)); S.st_k1 = load8(ROW(Kp, k0, 32 + sr)); } while (0)
#define SWRITE_HK(bf) do { *(bf16x8*)(K_lds + (bf) * SHM_K + kws) = S.st_k0; *(bf16x8*)(K_lds + (bf) * SHM_K + kws + 32 * 256) = S.st_k1; } while (0)
#define BDMA(Bp, k0, bf) do { if (wid == 0) __builtin_amdgcn_global_load_lds((const unsigned*)((Bp) + (k0) + lane), (__attribute__((address_space(3))) unsigned*)(unsigned)(uintptr_t)(B_lds + (bf) * 256), 4, 0, 0); } while (0)
#define SWRITE_HV(bf) do { *(bf16x8*)(V_lds + (bf) * SHM_V + vst0) = S.st_v0; *(bf16x8*)(V_lds + (bf) * SHM_V + vst1) = S.st_v1; } while (0)
#define SWRITE_H(bf) do { SWRITE_HV(bf); SWRITE_HK(bf); } while (0)
template <bool MM>
__device__ __forceinline__ void prime(const BlockRef& cur, char* lds, Seam& S) {
    int tid_ = threadIdx.x; asm volatile("" : "+v"(tid_));
    const int tid = tid_, wid = __builtin_amdgcn_readfirstlane(tid >> 6), lane = tid & 63, r32 = lane & 31, hi = lane >> 5;
    const int sr = tid >> 4, sc = (tid & 15) * 8, kws = KSWZ(sr, sc * 2); char* K_lds = lds + 2 * SHM_V; char* B_lds = lds + OFF_B;
#pragma unroll
    for (int d0 = 0; d0 < 8; ++d0) { const bf16x8 qf = load8(cur.K + Delta<MM>::DQ + (size_t)(cur.P0 + wid * QBLK + r32) * LDQ + d0 * 16 + hi * 8);
        if constexpr (MM) *reinterpret_cast<bf16x8*>(lds + OFF_Q + (wid * 8 + d0) * 1024 + lane * 16) = qf; else S.qr[d0] = qf; }
    BDMA(cur.CB, cur.t0 * KVBLK, 0); SLOAD_H(cur.K, cur.K + Delta<MM>::DV, cur.t0 * KVBLK); VMW(); SWRITE_HK(0);
    __syncthreads();
}
template <bool MM>
__device__ __forceinline__ void block(const BlockRef& cur, char* lds, Seam& S) {
    int tid_ = threadIdx.x; asm volatile("" : "+v"(tid_));
    const int tid = tid_, wid = __builtin_amdgcn_readfirstlane(tid >> 6), lane = tid & 63, r32 = lane & 31, hi = lane >> 5;
    const int NT = cur.nt;
    const int qlo = cur.P0 + wid * QBLK, qm = qlo + r32 - 4 * hi;
    char* V_lds = lds; char* K_lds = lds + 2 * SHM_V; char* B_lds = lds + OFF_B;
    float* ws = (float*)(lds + OFF_WS) + wid * 64; float* li_l = ws, * al_l = ws + 32;
    float m_reg = -1e30f, l_reg = 0; f32x16 o[4] = {};
    float m2row = 0.f; if constexpr (MM) m2row = cur.CB[32768 + qlo + r32];
    const char* qlds = lds + OFF_Q + wid * 8192 + lane * 16;
    const int sr = tid >> 4, sc = (tid & 15) * 8, vst0 = v_st(sr, sc), vst1 = v_st(32 + sr, sc), kws = KSWZ(sr, sc * 2);
    const int vb0 = (int)(uintptr_t)V_lds + v_rd_base(lane);
    const bf16* Kh = cur.K; const bf16* Vh = cur.K + Delta<MM>::DV; const float* Bh = cur.CB;
#define RESC(a) do { if (__any((a) < 1.f)) { if (hi == 0) al_l[r32] = (a); asm volatile("s_waitcnt lgkmcnt(0)" ::: "memory");              \
                     for (int d_ = 0; d_ < 4; ++d_) for (int r = 0; r < 16; ++r) o[d_][r] *= al_l[crow(r, hi)]; } } while (0)
#define KBASE(t) ((cur.t0 + (t)) * KVBLK)
#define MASKT(P0_, P1_, t) do { const int kb_ = KBASE(t); if (kb_ + KVBLK - 1 > qlo) mask_tile(P0_, P1_, qm - kb_); } while (0)
#define SMA(P0_, P1_, mnX, alX, t, BF) do { if constexpr (MM) { const int kb_ = KBASE(t); weightsM(P0_, P1_, B_lds + (BF) * 256, m2row, hi, kb_ + KVBLK - 1 > qlo, qm - kb_); } \
                                           else { MASKT(P0_, P1_, t); partialSM(P0_, P1_, m_reg, mnX, alX); } } while (0)
#define SMB(P0_, P1_, alY) do { if constexpr (MM) finishM(P0_, P1_, l_reg, pa0, pa1, pa2, pa3); else finishSM(P0_, P1_, alY, l_reg, pa0, pa1, pa2, pa3); } while (0)
    f32x16 pA0, pA1, pB0, pB1; float mnA, mnB, alA, alB; bf16x8 pa0, pa1, pa2, pa3;
    SWRITE_HV(0); SBAR();
    if (NT > 1) { BDMA(Bh, KBASE(1), 1); SLOAD_H(Kh, Vh, KBASE(1)); }
    SBAR(); qkt<0, MM>(pA0, pA1, K_lds, B_lds, r32, hi, S.qr, qlds);
    SMA(pA0, pA1, mnA, alA, 0, 0);
    if (NT > 1) { VMW(); SWRITE_H(1); }
    __syncthreads();
#define HALF_STEP(PX0, PX1, mnX, alX, PY0, PY1, alY, t, KB, VB, SB) do {                                                      \
        SBAR(); qkt<KB, MM>(PX0, PX1, K_lds, B_lds, r32, hi, S.qr, qlds);                                                    \
        SMB(PY0, PY1, alY); SBAR();                                                                                           \
        if ((t) + 1 < NT) { BDMA(Bh, KBASE((t) + 1), SB); SLOAD_H(Kh, Vh, KBASE((t) + 1)); SBAR(); }                          \
        pv_tile<VB>(o, vb0, pa0, pa1, pa2, pa3); SMA(PX0, PX1, mnX, alX, (t), KB);                                            \
        __syncthreads();                                                                                                      \
        if ((t) + 1 < NT) { VMW(); SWRITE_H(SB); }                                                                            \
        if constexpr (!MM) RESC(alX);                                                                                         \
        __syncthreads(); } while (0)
    for (int t = 1; t + 1 < NT; t += 2) {
        HALF_STEP(pB0, pB1, mnB, alB, pA0, pA1, alA, t, 1, 0, 0);
        HALF_STEP(pA0, pA1, mnA, alA, pB0, pB1, alB, t + 1, 0, 1, 1);
    }
    const bool even = (NT & 1) == 0;
    if (even) { SBAR(); qkt<1, MM>(pB0, pB1, K_lds, B_lds, r32, hi, S.qr, qlds); SBAR(); }
    SMB(pA0, pA1, alA); SBAR();
    pv_tile<0>(o, vb0, pa0, pa1, pa2, pa3);
    if (even) { SMA(pB0, pB1, mnB, alB, NT - 1, 1); __syncthreads(); if constexpr (!MM) RESC(alB);
        SMB(pB0, pB1, alB); SBAR(); pv_tile<1>(o, vb0, pa0, pa1, pa2, pa3); }
    if constexpr (MM) l_reg = fmaxf(fabsf(l_reg), cur.CB[65536 + qlo + r32]);
    if (hi == 0) li_l[r32] = l_reg; asm volatile("s_waitcnt lgkmcnt(0)" ::: "memory");
    float rli[16];
#pragma unroll
    for (int r = 0; r < 16; ++r) rli[r] = __builtin_amdgcn_rcpf(li_l[crow(r, hi)]);
    if constexpr (MM) {
        float* Ow = (float*)cur.Y + (size_t)(cur.P0 + wid * QBLK) * 512;
#pragma unroll
        for (int r = 0; r < 16; ++r) { const int orow = crow(r, hi);
#pragma unroll
            for (int d0 = 0; d0 < 4; ++d0) Ow[(size_t)orow * 512 + d0 * 32 + r32] = o[d0][r] * rli[r]; }
    } else if (cur.PO != nullptr) {
        if (hi == 0) { float* st = cur.ST + (size_t)(qlo + r32 - 2048) * 16; st[0] = m_reg; st[1] = l_reg; }
        float* Ow = cur.PO + (size_t)(qlo - 2048) * 1024 + r32;
#pragma unroll
        for (int r = 0; r < 16; ++r) { const int orow = crow(r, hi);
#pragma unroll
            for (int d0 = 0; d0 < 4; ++d0) Ow[(size_t)orow * 1024 + d0 * 32] = o[d0][r] * rli[r]; }
    } else {
    float nw[4];
#pragma unroll
    for (int d0 = 0; d0 < 4; ++d0) nw[d0] = cur.NW[d0 * 32 + r32];
    bf16* Yw = cur.Y + (size_t)(cur.P0 + wid * QBLK) * 2048 + r32;
#pragma unroll
    for (int r = 0; r < 16; ++r) { const int orow = crow(r, hi);
        const float v0 = o[0][r] * rli[r], v1 = o[1][r] * rli[r], v2 = o[2][r] * rli[r], v3 = o[3][r] * rli[r];
        float s2 = (v0 * v0 + v1 * v1) + (v2 * v2 + v3 * v3), s1 = (v0 + v1) + (v2 + v3);
        s2 += __shfl_xor(s2, 1); s2 += __shfl_xor(s2, 2); s2 += __shfl_xor(s2, 4); s2 += __shfl_xor(s2, 8); s2 += __shfl_xor(s2, 16);
        float mean = 0.f;
        if constexpr (MM) { s1 += __shfl_xor(s1, 1); s1 += __shfl_xor(s1, 2); s1 += __shfl_xor(s1, 4); s1 += __shfl_xor(s1, 8); s1 += __shfl_xor(s1, 16); mean = s1 * (1.0f / 128.0f); }
        const float rstd = 1.0f / sqrtf(fmaxf(s2 * (1.0f / 128.0f) - mean * mean, 0.f) + 1e-6f);
        float y0 = (v0 - mean) * rstd * nw[0], y1 = (v1 - mean) * rstd * nw[1], y2 = (v2 - mean) * rstd * nw[2], y3 = (v3 - mean) * rstd * nw[3];
        if constexpr (MM) { const bf16* gp = cur.K + Delta<MM>::DG + (size_t)(cur.P0 + wid * QBLK + orow) * LDQ + r32;
            const float g0 = __uint_as_float((unsigned)gp[0] << 16), g1 = __uint_as_float((unsigned)gp[32] << 16), g2 = __uint_as_float((unsigned)gp[64] << 16), g3 = __uint_as_float((unsigned)gp[96] << 16);
            y0 *= __builtin_amdgcn_rcpf(1.0f + __expf(-g0)); y1 *= __builtin_amdgcn_rcpf(1.0f + __expf(-g1)); y2 *= __builtin_amdgcn_rcpf(1.0f + __expf(-g2)); y3 *= __builtin_amdgcn_rcpf(1.0f + __expf(-g3)); }
        bf16* yp = Yw + (size_t)orow * 2048;
        yp[0] = (bf16)(cvtpk(y0, 0.f) & 0xffffu); yp[32] = (bf16)(cvtpk(y1, 0.f) & 0xffffu); yp[64] = (bf16)(cvtpk(y2, 0.f) & 0xffffu); yp[96] = (bf16)(cvtpk(y3, 0.f) & 0xffffu); }
    }
    __syncthreads();
#undef RESC
#undef KBASE
#undef MASKT
#undef SMA
#undef SMB
#undef HALF_STEP
}
#undef ROW
#undef VMW
#undef VMWN
#undef SLOAD_H
#undef SWRITE_HK
#undef SWRITE_HV
#undef BDMA
#undef SWRITE_H
#undef KSWZ
#undef SBAR
}

namespace gdn {
typedef unsigned short bf16;
typedef short bf16x8 __attribute__((ext_vector_type(8)));
typedef short s16x4 __attribute__((ext_vector_type(4)));
typedef float f32x16 __attribute__((ext_vector_type(16)));
typedef float f32x4 __attribute__((ext_vector_type(4)));
typedef unsigned u32x4 __attribute__((ext_vector_type(4)));
typedef unsigned u32x2 __attribute__((ext_vector_type(2)));
constexpr int PK_WKN = 0, PK_QD = 16384, PK_AT = 32768, PK_KE = 38912, PK_BYTES = 55296, WV_BYTES = 16384;
constexpr int L_Q = 0, L_K = 16384, L_KV = 32768, L_VV = 49152, L_A = 65536, L_T2 = 82944, L_T1 = 92160, L_TD = 101376, L_XM = L_TD + 2 * 32 * 33 * 4, L_RAW = 65536  , L_WC = 117248  , L_SM = L_WC + 6144, PREP_LDS = L_SM + 5 * 256;
static_assert(L_RAW + 67 * 768 <= L_WC && L_XM + 32 * 33 * 4 <= L_WC, "gdn prep lds");
constexpr int A_LD = 68, T_LD = 72;
#define G_KSWZ(row, colB) ((row) * 256 + ((colB) ^ (((row) & 7) << 4)))
#define G_SBAR() __builtin_amdgcn_sched_barrier(0)
__device__ __forceinline__ int v_st(int k, int c) { const int kk = (k & ~0xC) | ((k & 4) << 1) | ((k & 8) >> 1); return ((kk >> 3) * 4 + (c >> 5)) * 512 + ((kk & 7) * 32 + (c & 31)) * 2; }
__device__ __forceinline__ int v_rd_base(int lane) { return ((lane & 3) << 3) | (((lane >> 2) & 3) << 6) | (((lane >> 4) & 1) << 5) | (((lane >> 5) & 1) << 8); }
__device__ __forceinline__ int crow(int r, int hi) { return (r & 3) + 8 * (r >> 2) + 4 * hi; }
typedef float f32x2_t __attribute__((ext_vector_type(2))); typedef __bf16 bf16x2_t __attribute__((ext_vector_type(2)));
__device__ __forceinline__ unsigned cvtpk(float lo, float hi) { f32x2_t v = {lo, hi}; bf16x2_t b = __builtin_convertvector(v, bf16x2_t); return __builtin_bit_cast(unsigned, b); }
__device__ __forceinline__ bf16x8 pack8(float a0, float a1, float a2, float a3, float a4, float a5, float a6, float a7) {
    u32x4 w = {cvtpk(a0, a1), cvtpk(a2, a3), cvtpk(a4, a5), cvtpk(a6, a7)}; return *reinterpret_cast<bf16x8*>(&w); }
__device__ __forceinline__ float blo(unsigned u) { return __uint_as_float(u << 16); }
__device__ __forceinline__ float bhi(unsigned u) { return __uint_as_float(u & 0xffff0000u); }
#define G_TR4(vb, d0, L0, H0, L1, H1, L2, H2, L3, H3) do { \
    asm volatile("ds_read_b64_tr_b16 %0, %1 offset:%2" : "=&v"(L0) : "v"(vb), "i"((d0) * 512) : "memory"); asm volatile("ds_read_b64_tr_b16 %0, %1 offset:%2" : "=&v"(H0) : "v"(vb), "i"((d0) * 512 + 2048) : "memory"); \
    asm volatile("ds_read_b64_tr_b16 %0, %1 offset:%2" : "=&v"(L1) : "v"(vb), "i"((d0) * 512 + 4096) : "memory"); asm volatile("ds_read_b64_tr_b16 %0, %1 offset:%2" : "=&v"(H1) : "v"(vb), "i"((d0) * 512 + 6144) : "memory"); \
    asm volatile("ds_read_b64_tr_b16 %0, %1 offset:%2" : "=&v"(L2) : "v"(vb), "i"((d0) * 512 + 8192) : "memory"); asm volatile("ds_read_b64_tr_b16 %0, %1 offset:%2" : "=&v"(H2) : "v"(vb), "i"((d0) * 512 + 10240) : "memory"); \
    asm volatile("ds_read_b64_tr_b16 %0, %1 offset:%2" : "=&v"(L3) : "v"(vb), "i"((d0) * 512 + 12288) : "memory"); asm volatile("ds_read_b64_tr_b16 %0, %1 offset:%2" : "=&v"(H3) : "v"(vb), "i"((d0) * 512 + 14336) : "memory"); \
    asm volatile("s_waitcnt lgkmcnt(0)" ::: "memory"); G_SBAR(); } while (0)
#define G_FR(L, H) ((bf16x8){L[0], L[1], L[2], L[3], H[0], H[1], H[2], H[3]})

__device__ __forceinline__ void prep_unit(int u, const bf16* P, const float* GR, const float* conv_w, const float* a_log, const float* dt_bias,
                                          unsigned char* GPK, float* GWV, float* GEG, char* lds) {
    int tid_ = threadIdx.x; asm volatile("" : "+v"(tid_));
    const int tid = tid_, lane = tid & 63, wid = __builtin_amdgcn_readfirstlane(tid >> 6), r32 = lane & 31, hi = lane >> 5;
    const int bh = u >> 6, n = u & 63, b = bh >> 2, h = bh & 3; const size_t row0 = (size_t)b * 4096 + (size_t)n * 64;
    float* sm_gc = (float*)(lds + L_SM); float* sm_beta = sm_gc + 64; float* sm_eg = sm_gc + 128; float* sm_kew = sm_gc + 192; float* sm_bg = sm_gc + 256;
    { char* RAW = lds + L_RAW; float* WC = (float*)(lds + L_WC);
      for (int c = tid; c < 67 * 48; c += 512) { const int r = c / 48, q = c % 48, g = q >> 4, cc = q & 15;
          u32x4 x = {0u, 0u, 0u, 0u};
          if (n * 64 - 3 + r >= 0) x = *(const u32x4*)(P + (row0 + r - 3) * 7168 + 5120 + g * 512 + h * 128 + cc * 8);
          *(u32x4*)(RAW + r * 768 + g * 256 + cc * 16) = x; }
      for (int c = tid; c < 4 * 3 * 32; c += 512) { const int j = c / 96, q = c % 96, g = q >> 5, cc = q & 31;
          *(f32x4*)(WC + (j * 3 + g) * 128 + cc * 4) = *(const f32x4*)(conv_w + j * 1536 + g * 512 + h * 128 + cc * 4); }
    }
    __syncthreads();
    { const int tok = tid >> 3, e8 = tid & 7; const char* RAW = lds + L_RAW; const float* WC = (const float*)(lds + L_WC);
#pragma unroll
      for (int g = 0; g < 3; ++g) {
        float acc[16];
#pragma unroll
        for (int i = 0; i < 16; ++i) acc[i] = 0.f;
#pragma unroll
        for (int j = 0; j < 4; ++j) {
            const char* src = RAW + (tok + j) * 768 + g * 256 + e8 * 32;
            const u32x4 x0 = *(const u32x4*)src, x1 = *(const u32x4*)(src + 16);
            const float* wp = WC + (j * 3 + g) * 128 + e8 * 16;
            const f32x4 w0 = *(const f32x4*)wp, w1 = *(const f32x4*)(wp + 4), w2 = *(const f32x4*)(wp + 8), w3 = *(const f32x4*)(wp + 12);
            acc[0] += w0[0] * blo(x0[0]); acc[1] += w0[1] * bhi(x0[0]); acc[2] += w0[2] * blo(x0[1]); acc[3] += w0[3] * bhi(x0[1]);
            acc[4] += w1[0] * blo(x0[2]); acc[5] += w1[1] * bhi(x0[2]); acc[6] += w1[2] * blo(x0[3]); acc[7] += w1[3] * bhi(x0[3]);
            acc[8] += w2[0] * blo(x1[0]); acc[9] += w2[1] * bhi(x1[0]); acc[10] += w2[2] * blo(x1[1]); acc[11] += w2[3] * bhi(x1[1]);
            acc[12] += w3[0] * blo(x1[2]); acc[13] += w3[1] * bhi(x1[2]); acc[14] += w3[2] * blo(x1[3]); acc[15] += w3[3] * bhi(x1[3]);
        }
        float ss = 0.f;
#pragma unroll
        for (int i = 0; i < 16; ++i) { const float v = acc[i]; acc[i] = v / (1.0f + __expf(-v)); ss += acc[i] * acc[i]; }
        if (g < 2) { ss += __shfl_xor(ss, 1); ss += __shfl_xor(ss, 2); ss += __shfl_xor(ss, 4);
            const float rn = (1.0f / sqrtf(ss + 1e-6f)) * (g == 0 ? 0.08838834764831845f : 1.0f);
#pragma unroll
            for (int i = 0; i < 16; ++i) acc[i] *= rn; }
        const bf16x8 o0 = pack8(acc[0], acc[1], acc[2], acc[3], acc[4], acc[5], acc[6], acc[7]), o1 = pack8(acc[8], acc[9], acc[10], acc[11], acc[12], acc[13], acc[14], acc[15]);
        const int c0 = e8 * 16;
        if (g == 0) { *(bf16x8*)(lds + L_Q + G_KSWZ(tok, c0 * 2)) = o0; *(bf16x8*)(lds + L_Q + G_KSWZ(tok, c0 * 2 + 16)) = o1; }
        else if (g == 1) { *(bf16x8*)(lds + L_K + G_KSWZ(tok, c0 * 2)) = o0; *(bf16x8*)(lds + L_K + G_KSWZ(tok, c0 * 2 + 16)) = o1;
                           *(bf16x8*)(lds + L_KV + v_st(tok, c0)) = o0; *(bf16x8*)(lds + L_KV + v_st(tok, c0 + 8)) = o1; }
        else { *(bf16x8*)(lds + L_VV + v_st(tok, c0)) = o0; *(bf16x8*)(lds + L_VV + v_st(tok, c0 + 8)) = o1; }
      }
      if (wid == 0) {
        const float rg = GR[(row0 + lane) * 32 + 16 + h], rb = GR[(row0 + lane) * 32 + 20 + h];
        const float xg = rg + dt_bias[h]; const float sp = fmaxf(xg, 0.f) + log1pf(expf(-fabsf(xg)));
        const float gt = -expf(a_log[h]) * sp, bt = 1.0f / (1.0f + expf(-rb));
        float gc = gt;
#pragma unroll
        for (int o = 1; o < 64; o <<= 1) { const float nb = __shfl_up(gc, o); if (lane >= o) gc += nb; }
        const float gl = __shfl(gc, 63);
        sm_gc[lane] = gc; sm_beta[lane] = bt; sm_eg[lane] = expf(gc); sm_kew[lane] = expf(gl - gc); sm_bg[lane] = bt * expf(gc);
        if (lane == 0) GEG[u] = expf(gl);
      }
    }
    __syncthreads();
    if (wid < 6) {
        const int prod = wid / 3, pr = wid % 3, tbp = (pr == 2) ? 1 : 0, tb = (pr == 0) ? 0 : 1;
        const char* Ab = lds + L_K + tbp * 32 * 256; const char* Bb = lds + (prod == 0 ? L_K : L_Q) + tb * 32 * 256;
        f32x16 acc = {};
#pragma unroll
        for (int d0 = 0; d0 < 8; ++d0) { const int off = G_KSWZ(r32, ((d0 & 3) * 16 + hi * 8) * 2) + (d0 >> 2) * 128;
            const bf16x8 a = *reinterpret_cast<const bf16x8*>(Ab + off), bb = *reinterpret_cast<const bf16x8*>(Bb + off);
            acc = __builtin_amdgcn_mfma_f32_32x32x16_bf16(a, bb, acc, 0, 0, 0); }
        const int t = 32 * tb + r32; const float gct = sm_gc[t], bt = sm_beta[t];
        float val[16];
#pragma unroll
        for (int g = 0; g < 4; ++g) { const int s0 = 32 * tbp + 8 * g + 4 * hi; const f32x4 gcs = *(const f32x4*)(sm_gc + s0);
#pragma unroll
            for (int j = 0; j < 4; ++j) { const int sp = s0 + j; const float e = acc[4 * g + j] * __expf(gct - gcs[j]);
                val[4 * g + j] = (prod == 0) ? ((sp < t) ? bt * e : 0.f) : ((sp <= t) ? e : 0.f); } }
        if (prod == 0) {
#pragma unroll
            for (int g = 0; g < 4; ++g) *(f32x4*)(lds + L_A + (t * A_LD + 32 * tbp + 8 * g + 4 * hi) * 4) = (f32x4){val[4 * g], val[4 * g + 1], val[4 * g + 2], val[4 * g + 3]};
        } else {
            const int pair = (pr == 0) ? 0 : (pr == 1 ? 1 : 2);
#pragma unroll
            for (int s = 0; s < 2; ++s) *(bf16x8*)(GPK + (size_t)u * PK_BYTES + PK_AT + (pair * 2 + s) * 1024 + lane * 16) =
                pack8(val[8 * s], val[8 * s + 1], val[8 * s + 2], val[8 * s + 3], val[8 * s + 4], val[8 * s + 5], val[8 * s + 6], val[8 * s + 7]);
        }
    }
    __syncthreads();
    float* TD = (float*)(lds + L_TD); float* XM = (float*)(lds + L_XM);
    if (wid < 2) {
        float tc[32]; const int jl = lane & 31;
        unsigned abase = (unsigned)(uintptr_t)(lds + L_A) + (unsigned)(wid * 32 * A_LD + wid * 32) * 4u; asm volatile("" : "+v"(abase));
#pragma unroll
        for (int i = 0; i < 32; ++i) { float a0 = (jl == i) ? 1.f : 0.f, a1 = 0.f, a2 = 0.f, a3 = 0.f;
#pragma unroll
            for (int l4 = 0; l4 < (i + 3) / 4; ++l4) { const f32x4 av = *(const __attribute__((address_space(3))) f32x4*)(abase + i * A_LD * 4 + l4 * 16);
                if (4 * l4 + 0 < i) a0 -= av[0] * tc[4 * l4 + 0]; if (4 * l4 + 1 < i) a1 -= av[1] * tc[4 * l4 + 1];
                if (4 * l4 + 2 < i) a2 -= av[2] * tc[4 * l4 + 2]; if (4 * l4 + 3 < i) a3 -= av[3] * tc[4 * l4 + 3]; }
            tc[i] = (a0 + a1) + (a2 + a3); }
        if (lane < 32) {
#pragma unroll
            for (int i = 0; i < 32; ++i) TD[(wid * 32 + i) * 33 + jl] = tc[i]; }
    } else {
        for (int f = wid - 2; f < 16; f += 6) { const int tb = f >> 3, i = (f >> 1) & 3, s = f & 1; const int t = 32 * tb + r32; const float eg = sm_eg[t];
            const int cb = (32 * i + 16 * s + 4 * hi) * 2;
            const u32x2 p0 = *(const u32x2*)(lds + L_Q + t * 256 + (((cb & ~15)) ^ ((t & 7) << 4)) + (cb & 8));
            const u32x2 p1 = *(const u32x2*)(lds + L_Q + t * 256 + ((((cb + 16) & ~15)) ^ ((t & 7) << 4)) + (cb & 8));
            *(bf16x8*)(GPK + (size_t)u * PK_BYTES + PK_QD + f * 1024 + lane * 16) =
                pack8(blo(p0[0]) * eg, bhi(p0[0]) * eg, blo(p0[1]) * eg, bhi(p0[1]) * eg, blo(p1[0]) * eg, bhi(p1[0]) * eg, blo(p1[1]) * eg, bhi(p1[1]) * eg); }
    }
    __syncthreads();
    { const int i = tid >> 4, j0 = (tid & 15) * 2;
      const float* ar = (const float*)(lds + L_A) + (32 + i) * A_LD; float x0 = 0.f, x1 = 0.f;
#pragma unroll 8
      for (int k = 0; k < 32; ++k) { const float av = ar[k]; x0 += av * TD[k * 33 + j0]; x1 += av * TD[k * 33 + j0 + 1]; }
      XM[i * 33 + j0] = x0; XM[i * 33 + j0 + 1] = x1; }
    __syncthreads();
    { const int i = tid >> 4, j0 = (tid & 15) * 2;
      float y0 = 0.f, y1 = 0.f;
#pragma unroll 8
      for (int k = 0; k < 32; ++k) { const float tv = TD[(32 + i) * 33 + k]; y0 -= tv * XM[k * 33 + j0]; y1 -= tv * XM[k * 33 + j0 + 1]; }
      unsigned* T2 = (unsigned*)(lds + L_T2); unsigned* T1 = (unsigned*)(lds + L_T1);
      const float be0 = sm_beta[j0], be1 = sm_beta[j0 + 1], bg0 = sm_bg[j0], bg1 = sm_bg[j0 + 1];
      const float ce0 = sm_beta[32 + j0], ce1 = sm_beta[33 + j0], cg0 = sm_bg[32 + j0], cg1 = sm_bg[33 + j0];
      const float t11a = TD[i * 33 + j0], t11b = TD[i * 33 + j0 + 1], t22a = TD[(32 + i) * 33 + j0], t22b = TD[(32 + i) * 33 + j0 + 1];
      T2[(i * T_LD + j0) >> 1] = cvtpk(t11a * be0, t11b * be1);                 T1[(i * T_LD + j0) >> 1] = cvtpk(t11a * bg0, t11b * bg1);
      T2[(i * T_LD + 32 + j0) >> 1] = 0u;                                        T1[(i * T_LD + 32 + j0) >> 1] = 0u;
      T2[((32 + i) * T_LD + j0) >> 1] = cvtpk(y0 * be0, y1 * be1);              T1[((32 + i) * T_LD + j0) >> 1] = cvtpk(y0 * bg0, y1 * bg1);
      T2[((32 + i) * T_LD + 32 + j0) >> 1] = cvtpk(t22a * ce0, t22b * ce1);     T1[((32 + i) * T_LD + 32 + j0) >> 1] = cvtpk(t22a * cg0, t22b * cg1); }
    __syncthreads();
    { const int tb = wid >> 2, dq = wid & 3;
      const int vbV = (int)(uintptr_t)(lds + L_VV) + v_rd_base(lane), vbK = (int)(uintptr_t)(lds + L_KV) + v_rd_base(lane);
      const char* t2p = lds + L_T2 + ((32 * tb + r32) * T_LD + 8 * hi) * 2; const char* t1p = lds + L_T1 + ((32 * tb + r32) * T_LD + 8 * hi) * 2;
      s16x4 l0, l1, l2, l3, h0, h1, h2, h3;
      { f32x16 acc = {};
        switch (dq) { case 0: G_TR4(vbV, 0, l0, h0, l1, h1, l2, h2, l3, h3); break; case 1: G_TR4(vbV, 1, l0, h0, l1, h1, l2, h2, l3, h3); break;
                      case 2: G_TR4(vbV, 2, l0, h0, l1, h1, l2, h2, l3, h3); break; default: G_TR4(vbV, 3, l0, h0, l1, h1, l2, h2, l3, h3); break; }
        acc = __builtin_amdgcn_mfma_f32_32x32x16_bf16(*reinterpret_cast<const bf16x8*>(t2p), G_FR(l0, h0), acc, 0, 0, 0);
        acc = __builtin_amdgcn_mfma_f32_32x32x16_bf16(*reinterpret_cast<const bf16x8*>(t2p + 32), G_FR(l1, h1), acc, 0, 0, 0);
        acc = __builtin_amdgcn_mfma_f32_32x32x16_bf16(*reinterpret_cast<const bf16x8*>(t2p + 64), G_FR(l2, h2), acc, 0, 0, 0);
        acc = __builtin_amdgcn_mfma_f32_32x32x16_bf16(*reinterpret_cast<const bf16x8*>(t2p + 96), G_FR(l3, h3), acc, 0, 0, 0);
        unsigned char* wv = (unsigned char*)GWV + (size_t)u * WV_BYTES + ((dq * 2 + tb) * 4) * 512 + lane * 8;
#pragma unroll
        for (int g = 0; g < 4; ++g) *(u32x2*)(wv + g * 512) = (u32x2){cvtpk(acc[4 * g], acc[4 * g + 1]), cvtpk(acc[4 * g + 2], acc[4 * g + 3])}; }
      switch (dq) { case 0: G_TR4(vbK, 0, l0, h0, l1, h1, l2, h2, l3, h3); break; case 1: G_TR4(vbK, 1, l0, h0, l1, h1, l2, h2, l3, h3); break;
                    case 2: G_TR4(vbK, 2, l0, h0, l1, h1, l2, h2, l3, h3); break; default: G_TR4(vbK, 3, l0, h0, l1, h1, l2, h2, l3, h3); break; }
      { f32x16 acc = {};
        acc = __builtin_amdgcn_mfma_f32_32x32x16_bf16(G_FR(l0, h0), *reinterpret_cast<const bf16x8*>(t1p), acc, 0, 0, 0);
        acc = __builtin_amdgcn_mfma_f32_32x32x16_bf16(G_FR(l1, h1), *reinterpret_cast<const bf16x8*>(t1p + 32), acc, 0, 0, 0);
        acc = __builtin_amdgcn_mfma_f32_32x32x16_bf16(G_FR(l2, h2), *reinterpret_cast<const bf16x8*>(t1p + 64), acc, 0, 0, 0);
        acc = __builtin_amdgcn_mfma_f32_32x32x16_bf16(G_FR(l3, h3), *reinterpret_cast<const bf16x8*>(t1p + 96), acc, 0, 0, 0);
#pragma unroll
        for (int s = 0; s < 2; ++s) *(bf16x8*)(GPK + (size_t)u * PK_BYTES + PK_WKN + (((tb * 4 + dq) * 2 + s)) * 1024 + lane * 16) =
            pack8(-acc[8 * s], -acc[8 * s + 1], -acc[8 * s + 2], -acc[8 * s + 3], -acc[8 * s + 4], -acc[8 * s + 5], -acc[8 * s + 6], -acc[8 * s + 7]); }
      { f32x16 acc = {}; const float kw = sm_kew[32 * tb + r32];
        bf16x8 dg0, dg1;
#pragma unroll
        for (int j = 0; j < 8; ++j) { const unsigned short wbits = (unsigned short)(cvtpk(kw, 0.f) & 0xffffu);
            dg0[j] = (short)((8 * hi + j == r32) ? wbits : 0); dg1[j] = (short)((16 + 8 * hi + j == r32) ? wbits : 0); }
        if (tb == 0) { acc = __builtin_amdgcn_mfma_f32_32x32x16_bf16(dg0, G_FR(l0, h0), acc, 0, 0, 0); acc = __builtin_amdgcn_mfma_f32_32x32x16_bf16(dg1, G_FR(l1, h1), acc, 0, 0, 0); }
        else { acc = __builtin_amdgcn_mfma_f32_32x32x16_bf16(dg0, G_FR(l2, h2), acc, 0, 0, 0); acc = __builtin_amdgcn_mfma_f32_32x32x16_bf16(dg1, G_FR(l3, h3), acc, 0, 0, 0); }
#pragma unroll
        for (int s = 0; s < 2; ++s) *(bf16x8*)(GPK + (size_t)u * PK_BYTES + PK_KE + (((dq * 2 + tb) * 2 + s)) * 1024 + lane * 16) =
            pack8(acc[8 * s], acc[8 * s + 1], acc[8 * s + 2], acc[8 * s + 3], acc[8 * s + 4], acc[8 * s + 5], acc[8 * s + 6], acc[8 * s + 7]); }
    }
    __syncthreads();
}


constexpr int MPK_QD = 0, MPK_AT = 16384, MPK_KE = 22528, MPK_BYTES = 38912, MWV_BYTES = 16384;
__device__ __forceinline__ void mlstm_prep_unit(int u, const bf16* P, const float* MB, const float* MM, unsigned char* GPK, unsigned char* GWV, float* GEG, char* lds) {
    int tid_ = threadIdx.x; asm volatile("" : "+v"(tid_));
    const int tid = tid_, lane = tid & 63, wid = __builtin_amdgcn_readfirstlane(tid >> 6), r32 = lane & 31, hi = lane >> 5;
    const int bh = u >> 6, n = u & 63, b = bh >> 2, h = bh & 3; const size_t row0 = (size_t)b * 4096 + (size_t)n * 64;
    float* sm_b2 = (float*)(lds + L_SM); float* sm_m2 = sm_b2 + 64; float* sm_qf = sm_b2 + 128; float* sm_kf = sm_b2 + 192;
    { const int tok = tid >> 3, e8 = tid & 7, c0 = e8 * 16; const bf16* src = P + (row0 + tok) * 7168 + h * 128 + c0;
      const bf16x8 q0 = *(const bf16x8*)(src), q1 = *(const bf16x8*)(src + 8), k0 = *(const bf16x8*)(src + 512), k1 = *(const bf16x8*)(src + 520), v0 = *(const bf16x8*)(src + 1024), v1 = *(const bf16x8*)(src + 1032);
      *(bf16x8*)(lds + L_Q + G_KSWZ(tok, c0 * 2)) = q0; *(bf16x8*)(lds + L_Q + G_KSWZ(tok, c0 * 2 + 16)) = q1;
      *(bf16x8*)(lds + L_K + G_KSWZ(tok, c0 * 2)) = k0; *(bf16x8*)(lds + L_K + G_KSWZ(tok, c0 * 2 + 16)) = k1;
      *(bf16x8*)(lds + L_KV + v_st(tok, c0)) = k0; *(bf16x8*)(lds + L_KV + v_st(tok, c0 + 8)) = k1;
      *(bf16x8*)(lds + L_VV + v_st(tok, c0)) = v0; *(bf16x8*)(lds + L_VV + v_st(tok, c0 + 8)) = v1;
      bf16x8 idr = {0, 0, 0, 0, 0, 0, 0, 0};
#pragma unroll
      for (int j = 0; j < 8; ++j) idr[j] = (short)((8 * e8 + j == tok) ? 0x3f80 : 0);
      *(bf16x8*)(lds + L_T2 + tok * (T_LD * 2) + e8 * 16) = idr;
      if (wid == 0) {
        const size_t o = (size_t)bh * 4096 + n * 64; const float b2 = MB[o + lane], m2 = MM[o + lane];
        const float rn = (n > 0) ? MM[o - 1] : MM[o], rn1 = __shfl(m2, 63);
        sm_b2[lane] = b2; sm_m2[lane] = m2; sm_qf[lane] = exp2f(rn - m2); sm_kf[lane] = 0.08838834764831845f * exp2f(b2 - rn1);
        if (lane == 0) GEG[u] = exp2f(rn - rn1);
      }
    }
    __syncthreads();
    if (wid < 3) {
        const int pr = wid, tbp = (pr == 2) ? 1 : 0, tb = (pr == 0) ? 0 : 1;
        const char* Ab = lds + L_K + tbp * 32 * 256; const char* Bb = lds + L_Q + tb * 32 * 256;
        f32x16 acc = {};
#pragma unroll
        for (int d0 = 0; d0 < 8; ++d0) { const int off = G_KSWZ(r32, ((d0 & 3) * 16 + hi * 8) * 2) + (d0 >> 2) * 128;
            const bf16x8 a = *reinterpret_cast<const bf16x8*>(Ab + off), bb = *reinterpret_cast<const bf16x8*>(Bb + off);
            acc = __builtin_amdgcn_mfma_f32_32x32x16_bf16(a, bb, acc, 0, 0, 0); }
        const int t = 32 * tb + r32; const float m2t = sm_m2[t];
        float val[16];
#pragma unroll
        for (int g = 0; g < 4; ++g) { const int s0 = 32 * tbp + 8 * g + 4 * hi; const f32x4 b2s = *(const f32x4*)(sm_b2 + s0);
#pragma unroll
            for (int j = 0; j < 4; ++j) { const int sp = s0 + j; const float e = acc[4 * g + j] * (0.08838834764831845f * __builtin_amdgcn_exp2f(fminf(b2s[j] - m2t, 0.f)));
                val[4 * g + j] = (sp <= t) ? e : 0.f; } }
        const int pair = (pr == 0) ? 0 : (pr == 1 ? 1 : 2);
#pragma unroll
        for (int s = 0; s < 2; ++s) *(bf16x8*)(GPK + (size_t)u * MPK_BYTES + MPK_AT + (pair * 2 + s) * 1024 + lane * 16) =
            pack8(val[8 * s], val[8 * s + 1], val[8 * s + 2], val[8 * s + 3], val[8 * s + 4], val[8 * s + 5], val[8 * s + 6], val[8 * s + 7]);
    } else {
        for (int f = wid - 3; f < 16; f += 5) { const int tb = f >> 3, i = (f >> 1) & 3, s = f & 1; const int t = 32 * tb + r32; const float eg = sm_qf[t];
            const int cb = (32 * i + 16 * s + 4 * hi) * 2;
            const u32x2 p0 = *(const u32x2*)(lds + L_Q + t * 256 + (((cb & ~15)) ^ ((t & 7) << 4)) + (cb & 8));
            const u32x2 p1 = *(const u32x2*)(lds + L_Q + t * 256 + ((((cb + 16) & ~15)) ^ ((t & 7) << 4)) + (cb & 8));
            *(bf16x8*)(GPK + (size_t)u * MPK_BYTES + MPK_QD + f * 1024 + lane * 16) =
                pack8(blo(p0[0]) * eg, bhi(p0[0]) * eg, blo(p0[1]) * eg, bhi(p0[1]) * eg, blo(p1[0]) * eg, bhi(p1[0]) * eg, blo(p1[1]) * eg, bhi(p1[1]) * eg); }
    }
    { const int tb = wid >> 2, dq = wid & 3;
      const int vbV = (int)(uintptr_t)(lds + L_VV) + v_rd_base(lane), vbK = (int)(uintptr_t)(lds + L_KV) + v_rd_base(lane);
      const char* t2p = lds + L_T2 + ((32 * tb + r32) * T_LD + 8 * hi) * 2;
      s16x4 l0, l1, l2, l3, h0, h1, h2, h3;
      { f32x16 acc = {};
        switch (dq) { case 0: G_TR4(vbV, 0, l0, h0, l1, h1, l2, h2, l3, h3); break; case 1: G_TR4(vbV, 1, l0, h0, l1, h1, l2, h2, l3, h3); break;
                      case 2: G_TR4(vbV, 2, l0, h0, l1, h1, l2, h2, l3, h3); break; default: G_TR4(vbV, 3, l0, h0, l1, h1, l2, h2, l3, h3); break; }
        acc = __builtin_amdgcn_mfma_f32_32x32x16_bf16(*reinterpret_cast<const bf16x8*>(t2p), G_FR(l0, h0), acc, 0, 0, 0);
        acc = __builtin_amdgcn_mfma_f32_32x32x16_bf16(*reinterpret_cast<const bf16x8*>(t2p + 32), G_FR(l1, h1), acc, 0, 0, 0);
        acc = __builtin_amdgcn_mfma_f32_32x32x16_bf16(*reinterpret_cast<const bf16x8*>(t2p + 64), G_FR(l2, h2), acc, 0, 0, 0);
        acc = __builtin_amdgcn_mfma_f32_32x32x16_bf16(*reinterpret_cast<const bf16x8*>(t2p + 96), G_FR(l3, h3), acc, 0, 0, 0);
        unsigned char* wv = GWV + (size_t)u * MWV_BYTES + ((dq * 2 + tb) * 4) * 512 + lane * 8;
#pragma unroll
        for (int g = 0; g < 4; ++g) *(u32x2*)(wv + g * 512) = (u32x2){cvtpk(acc[4 * g], acc[4 * g + 1]), cvtpk(acc[4 * g + 2], acc[4 * g + 3])}; }
      switch (dq) { case 0: G_TR4(vbK, 0, l0, h0, l1, h1, l2, h2, l3, h3); break; case 1: G_TR4(vbK, 1, l0, h0, l1, h1, l2, h2, l3, h3); break;
                    case 2: G_TR4(vbK, 2, l0, h0, l1, h1, l2, h2, l3, h3); break; default: G_TR4(vbK, 3, l0, h0, l1, h1, l2, h2, l3, h3); break; }
      { f32x16 acc = {}; const float kw = sm_kf[32 * tb + r32];
        bf16x8 dg0, dg1;
#pragma unroll
        for (int j = 0; j < 8; ++j) { const unsigned short wbits = (unsigned short)(cvtpk(kw, 0.f) & 0xffffu);
            dg0[j] = (short)((8 * hi + j == r32) ? wbits : 0); dg1[j] = (short)((16 + 8 * hi + j == r32) ? wbits : 0); }
        if (tb == 0) { acc = __builtin_amdgcn_mfma_f32_32x32x16_bf16(dg0, G_FR(l0, h0), acc, 0, 0, 0); acc = __builtin_amdgcn_mfma_f32_32x32x16_bf16(dg1, G_FR(l1, h1), acc, 0, 0, 0); }
        else { acc = __builtin_amdgcn_mfma_f32_32x32x16_bf16(dg0, G_FR(l2, h2), acc, 0, 0, 0); acc = __builtin_amdgcn_mfma_f32_32x32x16_bf16(dg1, G_FR(l3, h3), acc, 0, 0, 0); }
#pragma unroll
        for (int s = 0; s < 2; ++s) *(bf16x8*)(GPK + (size_t)u * MPK_BYTES + MPK_KE + (((dq * 2 + tb) * 2 + s)) * 1024 + lane * 16) =
            pack8(acc[8 * s], acc[8 * s + 1], acc[8 * s + 2], acc[8 * s + 3], acc[8 * s + 4], acc[8 * s + 5], acc[8 * s + 6], acc[8 * s + 7]); }
    }
    __syncthreads();
}
constexpr int SC_RA = 40960, SC_RB = 22528, SC_A0 = 0, SC_B0 = 2 * SC_RA, SC_OUT = SC_B0 + 2 * SC_RB, SC_OROW = 144, SC_EG = SC_OUT + 64 * SC_OROW, SC_LDS = SC_EG + 256;
typedef unsigned u32x4s __attribute__((ext_vector_type(4)));
__device__ __forceinline__ void scan_unit(int bh, int half, const unsigned char* GPK, const float* GWV, const float* GEG, float* HG, char* lds) {
    int tid_ = threadIdx.x; asm volatile("" : "+v"(tid_));
    const int tid = tid_, lane = tid & 63, wid = __builtin_amdgcn_readfirstlane(tid >> 6), r32 = lane & 31, hi = lane >> 5;
    const int b = bh >> 2, h = bh & 3;
    const unsigned lds0 = (unsigned)(uintptr_t)lds;
    if (tid < 64) ((float*)(lds + SC_EG))[tid] = GEG[bh * 64 + tid];
    __syncthreads();
#define S_BAR() do { asm volatile("" ::: "memory"); __builtin_amdgcn_s_barrier(); asm volatile("" ::: "memory"); } while (0)
    if (wid >= 2 && wid < 7) {
        const int lw = wid - 2;
        const unsigned char* srcW = (const unsigned char*)GWV + (size_t)(bh * 64) * WV_BYTES + half * 8192 + lane * 16;
        const unsigned char* srcP = GPK + (size_t)(bh * 64) * PK_BYTES + lane * 16;
#define S_GLDS(src_, dst_) __builtin_amdgcn_global_load_lds((const unsigned*)(src_), (__attribute__((address_space(3))) unsigned*)(dst_), 16, 0, 0)
#define S_DMA_A(n_) do { const unsigned d_ = lds0 + SC_A0 + ((n_) & 1) * SC_RA; const unsigned char* w_ = srcW + (size_t)(n_) * WV_BYTES; const unsigned char* p_ = srcP + (size_t)(n_) * PK_BYTES; \
            _Pragma("unroll") for (int i_ = 0; i_ < 8; ++i_) { const int q_ = lw + 5 * i_; const unsigned char* s_ = (q_ < 8) ? w_ + q_ * 1024 : p_ + (q_ - 8) * 1024; S_GLDS(s_, d_ + q_ * 1024); } } while (0)
#define S_DMA_B(n_) do { const unsigned d_ = lds0 + SC_B0 + ((n_) & 1) * SC_RB; const unsigned char* p_ = srcP + (size_t)(n_) * PK_BYTES + PK_AT; \
            _Pragma("unroll") for (int i_ = 0; i_ < 5; ++i_) { const int q_ = lw + 5 * i_; if (q_ < 22) S_GLDS(p_ + q_ * 1024, d_ + q_ * 1024); } } while (0)
#define S_WAIT2() do { if (lw < 2) asm volatile("s_waitcnt vmcnt(13)" ::: "memory"); else asm volatile("s_waitcnt vmcnt(12)" ::: "memory"); } while (0)
        S_DMA_A(0); S_DMA_B(0); S_DMA_A(1); S_WAIT2();
        for (int n = 0; n < 64; ++n) {
            S_BAR();
            if (n + 1 < 64) { S_DMA_B(n + 1); S_WAIT2(); } else { asm volatile("s_waitcnt vmcnt(0)" ::: "memory"); }
            S_BAR();
            if (n + 2 < 64) { S_DMA_A(n + 2); S_WAIT2(); } else { asm volatile("s_waitcnt vmcnt(0)" ::: "memory"); }
        }
        S_BAR();
#undef S_GLDS
#undef S_DMA_A
#undef S_DMA_B
#undef S_WAIT2
    } else if (wid == 7) {
        char* og = (char*)((bf16*)HG + ((size_t)b * 4096) * 512 + h * 128 + half * 64);
        const char* ob = lds + SC_OUT;
#define S_STORE(t_) do { _Pragma("unroll") for (int i_ = 0; i_ < 8; ++i_) { const int idx_ = lane + 64 * i_, tok_ = idx_ >> 3, seg_ = idx_ & 7; \
            const u32x4s v_ = *(const u32x4s*)(ob + tok_ * SC_OROW + seg_ * 16); *(u32x4s*)(og + (size_t)((t_) * 64 + tok_) * 1024 + seg_ * 16) = v_; } } while (0)
        for (int n = 0; n < 64; ++n) { S_BAR(); if (n > 0) { S_STORE(n - 1); asm volatile("s_waitcnt lgkmcnt(0)" ::: "memory"); } S_BAR(); }
        S_BAR(); S_STORE(63);
#undef S_STORE
    } else {
        f32x16 S0 = {}, S1 = {}, S2 = {}, S3 = {};
        const float* egt = (const float*)(lds + SC_EG);
        char* ow = lds + SC_OUT + (wid * 32 + r32) * 2;
#define G_PK(X, s_) pack8(X[8 * (s_)], X[8 * (s_) + 1], X[8 * (s_) + 2], X[8 * (s_) + 3], X[8 * (s_) + 4], X[8 * (s_) + 5], X[8 * (s_) + 6], X[8 * (s_) + 7])
#define G_A(p_) (*reinterpret_cast<const bf16x8*>(p_))
#define G_MF(A_, B_, C_) C_ = __builtin_amdgcn_mfma_f32_32x32x16_bf16(A_, B_, C_, 0, 0, 0)
#define SA_LOAD(set_, k_) do { F[set_][0] = G_A(bA + 8192 + (k_) * 1024); F[set_][1] = G_A(bA + 16384 + (k_) * 1024); F[set_][2] = G_A(bA + 24576 + (k_) * 1024); F[set_][3] = G_A(bA + 32768 + (k_) * 1024); } while (0)
#define SK_LOAD(set_, j_) do { F[set_][0] = G_A(bB + 6144 + (0 * 4 + (j_)) * 1024); F[set_][1] = G_A(bB + 6144 + (1 * 4 + (j_)) * 1024); F[set_][2] = G_A(bB + 6144 + (2 * 4 + (j_)) * 1024); F[set_][3] = G_A(bB + 6144 + (3 * 4 + (j_)) * 1024); } while (0)
#define S_DECAY(X, s_) do { _Pragma("unroll") for (int j_ = 0; j_ < 8; ++j_) X[8 * (s_) + j_] *= eg; } while (0)
#define STEP_A(k_, SPC, SPN, NX, ns_) do { G_SBAR(); if ((k_) + 2 < 8) SA_LOAD(((k_) + 2) % 3, (k_) + 2); G_SBAR(); \
            G_MF(F[(k_) % 3][0], SPC, U0); G_MF(F[(k_) % 3][1], SPC, U1); G_MF(F[(k_) % 3][2], SPC, O0); G_MF(F[(k_) % 3][3], SPC, O1); \
            if ((k_) + 1 < 8) { SPN = G_PK(NX, ns_); S_DECAY(NX, ns_); } } while (0)
#define S_OUT(OX, tb_, r0_) do { _Pragma("unroll") for (int r_ = (r0_); r_ < (r0_) + 8; r_ += 2) { const unsigned pk_ = cvtpk(OX[r_], OX[r_ + 1]); \
            *(unsigned short*)(ow + (32 * (tb_) + crow(r_, hi)) * SC_OROW) = (unsigned short)(pk_ & 0xffffu); *(unsigned short*)(ow + (32 * (tb_) + crow(r_ + 1, hi)) * SC_OROW) = (unsigned short)(pk_ >> 16); } } while (0)
        for (int n = 0; n < 64; ++n) {
            asm volatile("s_waitcnt lgkmcnt(0)" ::: "memory"); S_BAR();
            const char* bA = lds + SC_A0 + (n & 1) * SC_RA + lane * 16;
            const char* bB = lds + SC_B0 + (n & 1) * SC_RB + lane * 16;
            const char* wv = lds + SC_A0 + (n & 1) * SC_RA + wid * 4096 + lane * 8;
            const float eg = egt[n];
            bf16x8 F[3][6];
            u32x2 w[8];
#pragma unroll
            for (int g = 0; g < 4; ++g) { w[g] = *(const u32x2*)(wv + g * 512); w[4 + g] = *(const u32x2*)(wv + 2048 + g * 512); }
            SA_LOAD(0, 0); SA_LOAD(1, 1);
            bf16x8 spa = G_PK(S0, 0), spb; S_DECAY(S0, 0);
            f32x16 U0, U1, O0 = {}, O1 = {};
#pragma unroll
            for (int g = 0; g < 4; ++g) { U0[4 * g] = blo(w[g][0]); U0[4 * g + 1] = bhi(w[g][0]); U0[4 * g + 2] = blo(w[g][1]); U0[4 * g + 3] = bhi(w[g][1]);
                U1[4 * g] = blo(w[4 + g][0]); U1[4 * g + 1] = bhi(w[4 + g][0]); U1[4 * g + 2] = blo(w[4 + g][1]); U1[4 * g + 3] = bhi(w[4 + g][1]); }
            STEP_A(0, spa, spb, S0, 1); STEP_A(1, spb, spa, S1, 0); STEP_A(2, spa, spb, S1, 1); STEP_A(3, spb, spa, S2, 0);
            STEP_A(4, spa, spb, S2, 1); STEP_A(5, spb, spa, S3, 0); STEP_A(6, spa, spb, S3, 1); STEP_A(7, spb, spa, S3, 1);
            S_BAR();
            G_SBAR();
#pragma unroll
            for (int q = 0; q < 6; ++q) F[0][q] = G_A(bB + q * 1024);
            SK_LOAD(1, 0);
            G_SBAR();
            const bf16x8 up0 = G_PK(U0, 0), up1 = G_PK(U0, 1), up2 = G_PK(U1, 0), up3 = G_PK(U1, 1);
            G_SBAR(); SK_LOAD(2, 1); G_SBAR();
            G_MF(F[0][0], up0, O0); G_MF(F[0][2], up0, O1); G_MF(F[0][1], up1, O0); G_MF(F[0][3], up1, O1); G_MF(F[0][4], up2, O1); G_MF(F[0][5], up3, O1);
            G_SBAR(); SK_LOAD(0, 2); G_SBAR();
            G_MF(F[1][0], up0, S0); G_MF(F[1][1], up0, S1); G_MF(F[1][2], up0, S2); G_MF(F[1][3], up0, S3);
            S_OUT(O0, 0, 0); S_OUT(O0, 0, 8);
            G_SBAR(); SK_LOAD(1, 3); G_SBAR();
            G_MF(F[2][0], up1, S0); G_MF(F[2][1], up1, S1); G_MF(F[2][2], up1, S2); G_MF(F[2][3], up1, S3);
            S_OUT(O1, 1, 0); S_OUT(O1, 1, 8);
            G_SBAR();
            G_MF(F[0][0], up2, S0); G_MF(F[0][1], up2, S1); G_MF(F[0][2], up2, S2); G_MF(F[0][3], up2, S3);
            G_MF(F[1][0], up3, S0); G_MF(F[1][1], up3, S1); G_MF(F[1][2], up3, S2); G_MF(F[1][3], up3, S3);
        }
        asm volatile("s_waitcnt lgkmcnt(0)" ::: "memory"); S_BAR();
#undef G_PK
#undef G_A
#undef G_MF
#undef SA_LOAD
#undef SK_LOAD
#undef S_DECAY
#undef STEP_A
#undef S_OUT
    }
#undef S_BAR
    __syncthreads();
}

constexpr int MS_RA = 24576, MS_RB = 22528, MS_A0 = 0, MS_B0 = 2 * MS_RA, MS_OUT = MS_B0 + 2 * MS_RB, MS_EG = MS_OUT + 64 * SC_OROW, MS_LDS = MS_EG + 256;
__device__ __forceinline__ void mscan2_unit(int bh, int half, const unsigned char* GPK, const unsigned char* GWV, const float* GEG, float* HM, float* DEN, char* lds) {
    int tid_ = threadIdx.x; asm volatile("" : "+v"(tid_));
    const int tid = tid_, lane = tid & 63, wid = __builtin_amdgcn_readfirstlane(tid >> 6), r32 = lane & 31, hi = lane >> 5;
    const int b = bh >> 2, h = bh & 3;
    const unsigned lds0 = (unsigned)(uintptr_t)lds;
    if (tid < 64) ((float*)(lds + MS_EG))[tid] = GEG[bh * 64 + tid];
    __syncthreads();
#define S_BAR() do { asm volatile("" ::: "memory"); __builtin_amdgcn_s_barrier(); asm volatile("" ::: "memory"); } while (0)
    if (wid >= 3 && wid < 7) {
        const int lw = wid - 3;
        const unsigned char* srcW = GWV + (size_t)(bh * 64) * MWV_BYTES + half * 8192 + lane * 16;
        const unsigned char* srcP = GPK + (size_t)(bh * 64) * MPK_BYTES + lane * 16;
#define S_GLDS(src_, dst_) __builtin_amdgcn_global_load_lds((const unsigned*)(src_), (__attribute__((address_space(3))) unsigned*)(dst_), 16, 0, 0)
#define S_DMA_A(n_) do { const unsigned d_ = lds0 + MS_A0 + ((n_) & 1) * MS_RA; const unsigned char* w_ = srcW + (size_t)(n_) * MWV_BYTES; const unsigned char* p_ = srcP + (size_t)(n_) * MPK_BYTES + MPK_QD; \
            _Pragma("unroll") for (int i_ = 0; i_ < 6; ++i_) { const int q_ = lw + 4 * i_; const unsigned char* s_ = (q_ < 8) ? w_ + q_ * 1024 : p_ + (q_ - 8) * 1024; S_GLDS(s_, d_ + q_ * 1024); } } while (0)
#define S_DMA_B(n_) do { const unsigned d_ = lds0 + MS_B0 + ((n_) & 1) * MS_RB; const unsigned char* p_ = srcP + (size_t)(n_) * MPK_BYTES + MPK_AT; \
            _Pragma("unroll") for (int i_ = 0; i_ < 6; ++i_) { const int q_ = lw + 4 * i_; if (q_ < 22) S_GLDS(p_ + q_ * 1024, d_ + q_ * 1024); } } while (0)
#define S_WAIT2() do { if (lw < 2) asm volatile("s_waitcnt vmcnt(12)" ::: "memory"); else asm volatile("s_waitcnt vmcnt(11)" ::: "memory"); } while (0)
        S_DMA_A(0); S_DMA_B(0); S_DMA_A(1); S_WAIT2();
        for (int n = 0; n < 64; ++n) {
            S_BAR();
            if (n + 1 < 64) { S_DMA_B(n + 1); S_WAIT2(); } else { asm volatile("s_waitcnt vmcnt(0)" ::: "memory"); }
            S_BAR();
            if (n + 2 < 64) { S_DMA_A(n + 2); S_WAIT2(); } else { asm volatile("s_waitcnt vmcnt(0)" ::: "memory"); }
        }
        S_BAR();
#undef S_GLDS
#undef S_DMA_A
#undef S_DMA_B
#undef S_WAIT2
    } else if (wid == 7) {
        char* og = (char*)((bf16*)HM + ((size_t)b * 4096) * 512 + h * 128 + half * 64);
        const char* ob = lds + MS_OUT;
#define S_STORE(t_) do { _Pragma("unroll") for (int i_ = 0; i_ < 8; ++i_) { const int idx_ = lane + 64 * i_, tok_ = idx_ >> 3, seg_ = idx_ & 7; \
            const u32x4s v_ = *(const u32x4s*)(ob + tok_ * SC_OROW + seg_ * 16); *(u32x4s*)(og + (size_t)((t_) * 64 + tok_) * 1024 + seg_ * 16) = v_; } } while (0)
        for (int n = 0; n < 64; ++n) { S_BAR(); if (n > 0) { S_STORE(n - 1); asm volatile("s_waitcnt lgkmcnt(0)" ::: "memory"); } S_BAR(); }
        S_BAR(); S_STORE(63);
#undef S_STORE
    } else if (wid == 2 && half != 0) {
        for (int n = 0; n < 64; ++n) { S_BAR(); S_BAR(); }
        S_BAR();
    } else {
        const bool den = (wid == 2);
        f32x16 S0 = {}, S1 = {}, S2 = {}, S3 = {};
        const float* egt = (const float*)(lds + MS_EG);
        char* ow = lds + MS_OUT + (wid * 32 + r32) * 2;
        const float one0 = (r32 == 0) ? 1.f : 0.f;
        const bf16x8 ones = pack8(one0, one0, one0, one0, one0, one0, one0, one0);
#define G_PK(X, s_) pack8(X[8 * (s_)], X[8 * (s_) + 1], X[8 * (s_) + 2], X[8 * (s_) + 3], X[8 * (s_) + 4], X[8 * (s_) + 5], X[8 * (s_) + 6], X[8 * (s_) + 7])
#define G_A(p_) (*reinterpret_cast<const bf16x8*>(p_))
#define G_MF(A_, B_, C_) C_ = __builtin_amdgcn_mfma_f32_32x32x16_bf16(A_, B_, C_, 0, 0, 0)
#define SA_LOAD(set_, j_) do { F[set_][0] = G_A(bA + 8192 + (2 * (j_)) * 1024); F[set_][1] = G_A(bA + 16384 + (2 * (j_)) * 1024); F[set_][2] = G_A(bA + 8192 + (2 * (j_) + 1) * 1024); F[set_][3] = G_A(bA + 16384 + (2 * (j_) + 1) * 1024); } while (0)
#define SK_LOAD(set_, j_) do { F[set_][0] = G_A(bB + 6144 + (0 * 4 + (j_)) * 1024); F[set_][1] = G_A(bB + 6144 + (1 * 4 + (j_)) * 1024); F[set_][2] = G_A(bB + 6144 + (2 * 4 + (j_)) * 1024); F[set_][3] = G_A(bB + 6144 + (3 * 4 + (j_)) * 1024); } while (0)
#define S_DECAY2(X) do { X *= eg; } while (0)
#define STEP_A(j_, NX) do { G_SBAR(); if ((j_) + 2 < 4) SA_LOAD(((j_) + 2) % 3, (j_) + 2); G_SBAR(); \
            G_MF(F[(j_) % 3][0], spa, O0); G_MF(F[(j_) % 3][1], spa, O1); G_MF(F[(j_) % 3][2], spb, O0); G_MF(F[(j_) % 3][3], spb, O1); \
            if ((j_) + 1 < 4) { spa = G_PK(NX, 0); spb = G_PK(NX, 1); S_DECAY2(NX); } } while (0)
#define S_OUT(OX, tb_, r0_) do { _Pragma("unroll") for (int r_ = (r0_); r_ < (r0_) + 8; r_ += 2) { const unsigned pk_ = cvtpk(OX[r_], OX[r_ + 1]); \
            *(unsigned short*)(ow + (32 * (tb_) + crow(r_, hi)) * SC_OROW) = (unsigned short)(pk_ & 0xffffu); *(unsigned short*)(ow + (32 * (tb_) + crow(r_ + 1, hi)) * SC_OROW) = (unsigned short)(pk_ >> 16); } } while (0)
        for (int n = 0; n < 64; ++n) {
            asm volatile("s_waitcnt lgkmcnt(0)" ::: "memory"); S_BAR();
            const char* bA = lds + MS_A0 + (n & 1) * MS_RA + lane * 16;
            const char* bB = lds + MS_B0 + (n & 1) * MS_RB + lane * 16;
            const char* wv = lds + MS_A0 + (n & 1) * MS_RA + (wid & 1) * 4096 + lane * 8;
            const float eg = egt[n];
            bf16x8 F[3][6];
            u32x2 w[8];
#pragma unroll
            for (int g = 0; g < 4; ++g) { w[g] = *(const u32x2*)(wv + g * 512); w[4 + g] = *(const u32x2*)(wv + 2048 + g * 512); }
            SA_LOAD(0, 0); SA_LOAD(1, 1);
            bf16x8 spa = G_PK(S0, 0), spb = G_PK(S0, 1); S_DECAY2(S0);
            f32x16 O0 = {}, O1 = {};
            bf16x8 up0, up1, up2, up3;
            { typedef unsigned u32x4b __attribute__((ext_vector_type(4)));
              const u32x4b q0 = {w[0][0], w[0][1], w[1][0], w[1][1]}, q1 = {w[2][0], w[2][1], w[3][0], w[3][1]}, q2 = {w[4][0], w[4][1], w[5][0], w[5][1]}, q3 = {w[6][0], w[6][1], w[7][0], w[7][1]};
              up0 = den ? ones : __builtin_bit_cast(bf16x8, q0); up1 = den ? ones : __builtin_bit_cast(bf16x8, q1); up2 = den ? ones : __builtin_bit_cast(bf16x8, q2); up3 = den ? ones : __builtin_bit_cast(bf16x8, q3); }
            STEP_A(0, S1); STEP_A(1, S2); STEP_A(2, S3); STEP_A(3, S3);
            S_BAR();
            G_SBAR();
#pragma unroll
            for (int q = 0; q < 6; ++q) F[0][q] = G_A(bB + q * 1024);
            SK_LOAD(1, 0);
            G_SBAR(); SK_LOAD(2, 1); G_SBAR();
            G_MF(F[0][0], up0, O0); G_MF(F[0][2], up0, O1); G_MF(F[0][1], up1, O0); G_MF(F[0][3], up1, O1); G_MF(F[0][4], up2, O1); G_MF(F[0][5], up3, O1);
            G_SBAR(); SK_LOAD(0, 2); G_SBAR();
            G_MF(F[1][0], up0, S0); G_MF(F[1][1], up0, S1); G_MF(F[1][2], up0, S2); G_MF(F[1][3], up0, S3);
            if (!den) { S_OUT(O0, 0, 0); S_OUT(O0, 0, 8); }
            G_SBAR(); SK_LOAD(1, 3); G_SBAR();
            G_MF(F[2][0], up1, S0); G_MF(F[2][1], up1, S1); G_MF(F[2][2], up1, S2); G_MF(F[2][3], up1, S3);
            if (!den) { S_OUT(O1, 1, 0); S_OUT(O1, 1, 8); }
            else { float* dg = DEN + ((size_t)b * 4096 + (size_t)n * 64) * 4 + h;
#pragma unroll
                for (int r = 0; r < 16; ++r) { if (r32 == 0) dg[(size_t)crow(r, hi) * 4] = O0[r]; if (r32 == 0) dg[(size_t)(32 + crow(r, hi)) * 4] = O1[r]; } }
            G_SBAR();
            G_MF(F[0][0], up2, S0); G_MF(F[0][1], up2, S1); G_MF(F[0][2], up2, S2); G_MF(F[0][3], up2, S3);
            G_MF(F[1][0], up3, S0); G_MF(F[1][1], up3, S1); G_MF(F[1][2], up3, S2); G_MF(F[1][3], up3, S3);
        }
        asm volatile("s_waitcnt lgkmcnt(0)" ::: "memory"); S_BAR();
#undef G_PK
#undef G_A
#undef G_MF
#undef SA_LOAD
#undef SK_LOAD
#undef S_DECAY2
#undef STEP_A
#undef S_OUT
    }
#undef S_BAR
    __syncthreads();
}

__device__ __forceinline__ void mscan_unit(int bh, const unsigned char* GPK, const unsigned char* GWV, const float* GEG, float* HM, float* DEN, char* lds) {
    int tid_ = threadIdx.x; asm volatile("" : "+v"(tid_));
    const int tid = tid_, lane = tid & 63, wid = __builtin_amdgcn_readfirstlane(tid >> 6), r32 = lane & 31, hi = lane >> 5;
    const int b = bh >> 2, h = bh & 3;
    const unsigned lds0 = (unsigned)(uintptr_t)lds;
    if (wid >= 5) {
        const int lw = wid - 5;
#define M_DMA(n_) do { const unsigned char* src_ = GPK + (size_t)(bh * 64 + (n_)) * MPK_BYTES + lane * 16; const unsigned dst_ = lds0 + ((n_) % 3) * MPK_BYTES; \
        for (int p_ = lw; p_ < 38; p_ += 3) __builtin_amdgcn_global_load_lds((const unsigned*)(src_ + p_ * 1024), (__attribute__((address_space(3))) unsigned*)(dst_ + p_ * 1024), 16, 0, 0); } while (0)
#define M_WAIT_OLDER() do { if (lw < 2) asm volatile("s_waitcnt vmcnt(13)" ::: "memory"); else asm volatile("s_waitcnt vmcnt(12)" ::: "memory"); } while (0)
        M_DMA(0); M_DMA(1); M_WAIT_OLDER();
        for (int n = 0; n < 64; ++n) {
            asm volatile("" ::: "memory"); __builtin_amdgcn_s_barrier(); asm volatile("" ::: "memory");
            if (n + 2 < 64) { M_DMA(n + 2); M_WAIT_OLDER(); } else { asm volatile("s_waitcnt vmcnt(0)" ::: "memory"); }
        }
#undef M_DMA
#undef M_WAIT_OLDER
    } else {
        f32x16 S0 = {}, S1 = {}, S2 = {}, S3 = {};
        u32x2 wn[8];
        const unsigned char* wvp = GWV + (size_t)(bh * 64) * MWV_BYTES + ((wid & 3) * 2 * 4) * 512 + lane * 8;
#define M_LDWV(n_) do { const unsigned char* p_ = wvp + (size_t)(n_) * MWV_BYTES; \
        _Pragma("unroll") for (int g_ = 0; g_ < 4; ++g_) { wn[g_] = *(const u32x2*)(p_ + g_ * 512); wn[4 + g_] = *(const u32x2*)(p_ + 2048 + g_ * 512); } } while (0)
#define M_UNPACK(A0, A1) do { _Pragma("unroll") for (int g = 0; g < 4; ++g) { A0[4 * g] = blo(wn[g][0]); A0[4 * g + 1] = bhi(wn[g][0]); A0[4 * g + 2] = blo(wn[g][1]); A0[4 * g + 3] = bhi(wn[g][1]); \
            A1[4 * g] = blo(wn[4 + g][0]); A1[4 * g + 1] = bhi(wn[4 + g][0]); A1[4 * g + 2] = blo(wn[4 + g][1]); A1[4 * g + 3] = bhi(wn[4 + g][1]); } } while (0)
        const float one0 = (r32 == 0) ? 1.f : 0.f;
        f32x16 U0, U1; M_LDWV(0); M_UNPACK(U0, U1);
        float eg = GEG[bh * 64];
        for (int n = 0; n < 64; ++n) {
            asm volatile("" ::: "memory"); __builtin_amdgcn_s_barrier(); asm volatile("" ::: "memory");
            const int nn = (n + 1 < 64) ? n + 1 : 63; M_LDWV(nn); const float egl = GEG[bh * 64 + nn];
            if (wid == 4) {
#pragma unroll
                for (int r = 0; r < 16; ++r) { U0[r] = one0; U1[r] = one0; } }
            const char* buf = lds + (n % 3) * MPK_BYTES + lane * 16;
#define G_PK(X, s_) pack8(X[8 * (s_)], X[8 * (s_) + 1], X[8 * (s_) + 2], X[8 * (s_) + 3], X[8 * (s_) + 4], X[8 * (s_) + 5], X[8 * (s_) + 6], X[8 * (s_) + 7])
            const bf16x8 sp00 = G_PK(S0, 0), sp01 = G_PK(S0, 1), sp10 = G_PK(S1, 0), sp11 = G_PK(S1, 1), sp20 = G_PK(S2, 0), sp21 = G_PK(S2, 1), sp30 = G_PK(S3, 0), sp31 = G_PK(S3, 1);
            S0 *= eg; S1 *= eg; S2 *= eg; S3 *= eg;
#define G_A(off_) (*reinterpret_cast<const bf16x8*>(buf + (off_)))
#define G_MM8(ACC, base_) do { ACC = __builtin_amdgcn_mfma_f32_32x32x16_bf16(G_A((base_) + 0 * 1024), sp00, ACC, 0, 0, 0); ACC = __builtin_amdgcn_mfma_f32_32x32x16_bf16(G_A((base_) + 1 * 1024), sp01, ACC, 0, 0, 0); \
                                ACC = __builtin_amdgcn_mfma_f32_32x32x16_bf16(G_A((base_) + 2 * 1024), sp10, ACC, 0, 0, 0); ACC = __builtin_amdgcn_mfma_f32_32x32x16_bf16(G_A((base_) + 3 * 1024), sp11, ACC, 0, 0, 0); \
                                ACC = __builtin_amdgcn_mfma_f32_32x32x16_bf16(G_A((base_) + 4 * 1024), sp20, ACC, 0, 0, 0); ACC = __builtin_amdgcn_mfma_f32_32x32x16_bf16(G_A((base_) + 5 * 1024), sp21, ACC, 0, 0, 0); \
                                ACC = __builtin_amdgcn_mfma_f32_32x32x16_bf16(G_A((base_) + 6 * 1024), sp30, ACC, 0, 0, 0); ACC = __builtin_amdgcn_mfma_f32_32x32x16_bf16(G_A((base_) + 7 * 1024), sp31, ACC, 0, 0, 0); } while (0)
            f32x16 O0 = {}, O1 = {};
            G_MM8(O0, MPK_QD); G_MM8(O1, MPK_QD + 8192);
            const bf16x8 up00 = G_PK(U0, 0), up01 = G_PK(U0, 1), up10 = G_PK(U1, 0), up11 = G_PK(U1, 1);
            O0 = __builtin_amdgcn_mfma_f32_32x32x16_bf16(G_A(MPK_AT + 0 * 1024), up00, O0, 0, 0, 0); O0 = __builtin_amdgcn_mfma_f32_32x32x16_bf16(G_A(MPK_AT + 1 * 1024), up01, O0, 0, 0, 0);
            O1 = __builtin_amdgcn_mfma_f32_32x32x16_bf16(G_A(MPK_AT + 2 * 1024), up00, O1, 0, 0, 0); O1 = __builtin_amdgcn_mfma_f32_32x32x16_bf16(G_A(MPK_AT + 3 * 1024), up01, O1, 0, 0, 0);
            O1 = __builtin_amdgcn_mfma_f32_32x32x16_bf16(G_A(MPK_AT + 4 * 1024), up10, O1, 0, 0, 0); O1 = __builtin_amdgcn_mfma_f32_32x32x16_bf16(G_A(MPK_AT + 5 * 1024), up11, O1, 0, 0, 0);
#define G_MMS(SX, i_) do { SX = __builtin_amdgcn_mfma_f32_32x32x16_bf16(G_A(MPK_KE + ((i_) * 4 + 0) * 1024), up00, SX, 0, 0, 0); SX = __builtin_amdgcn_mfma_f32_32x32x16_bf16(G_A(MPK_KE + ((i_) * 4 + 1) * 1024), up01, SX, 0, 0, 0); \
                               SX = __builtin_amdgcn_mfma_f32_32x32x16_bf16(G_A(MPK_KE + ((i_) * 4 + 2) * 1024), up10, SX, 0, 0, 0); SX = __builtin_amdgcn_mfma_f32_32x32x16_bf16(G_A(MPK_KE + ((i_) * 4 + 3) * 1024), up11, SX, 0, 0, 0); } while (0)
            G_MMS(S0, 0); G_MMS(S1, 1); G_MMS(S2, 2); G_MMS(S3, 3);
            M_UNPACK(U0, U1); eg = egl;
            const size_t rowb = (size_t)b * 4096 + (size_t)n * 64;
            if (wid < 4) { bf16* og = (bf16*)HM + rowb * 512 + h * 128 + wid * 32 + r32;
#pragma unroll
                for (int r = 0; r < 16; ++r) { og[(size_t)crow(r, hi) * 512] = (bf16)(cvtpk(O0[r], 0.f) & 0xffffu); og[(size_t)(32 + crow(r, hi)) * 512] = (bf16)(cvtpk(O1[r], 0.f) & 0xffffu); }
            } else { float* dg = DEN + rowb * 4 + h;
#pragma unroll
                for (int r = 0; r < 16; ++r) { if (r32 == 0) dg[(size_t)crow(r, hi) * 4] = O0[r]; if (r32 == 0) dg[(size_t)(32 + crow(r, hi)) * 4] = O1[r]; } }
#undef G_PK
#undef G_A
#undef G_MM8
#undef G_MMS
        }
#undef M_LDWV
#undef M_UNPACK
    }
    __syncthreads();
}
#undef G_KSWZ
#undef G_SBAR
#undef G_TR4
#undef G_FR
}

#define GAS __attribute__((address_space(1)))
#define LAS __attribute__((address_space(3)))
typedef unsigned short bf16;
typedef unsigned v4u __attribute__((ext_vector_type(4)));
typedef float f32x4 __attribute__((ext_vector_type(4)));
typedef short bf16x8 __attribute__((ext_vector_type(8)));
typedef GAS unsigned gu32;
typedef GAS unsigned long long gu64;
#define RLX_AGENT __ATOMIC_RELAXED, __HIP_MEMORY_SCOPE_AGENT
#define LDS_WAIT() asm volatile("s_waitcnt lgkmcnt(0)" ::: "memory")
#define VM_WAIT() asm volatile("s_waitcnt vmcnt(0)" ::: "memory")
__device__ __forceinline__ unsigned long long rt() { return __builtin_amdgcn_s_memrealtime(); }
__device__ __forceinline__ unsigned f2bf(float f) { unsigned u = __builtin_bit_cast(unsigned, f); return (u + 0x7fffu + ((u >> 16) & 1u)) >> 16; }
__device__ __forceinline__ unsigned pk2(float lo, float hi) { return f2bf(lo) | (f2bf(hi) << 16); }

#define XB_TMO      128
#define XB_XCNT(j)  (256  + 64 * (j))
#define XB_XSUB(j)  (1280 + 64 * (j))
#define XB_XGEN(j)  (2304 + 64 * (j))
#define XB_TOP      3328
#define XB_TOPGEN   3392
#define XCD_BAR_WORDS 3456
#define XB_SPIN_CAP (1u << 18)

__device__ __forceinline__ unsigned xb_ld(unsigned* p)              { return __hip_atomic_load(p, __ATOMIC_RELAXED, __HIP_MEMORY_SCOPE_AGENT); }
__device__ __forceinline__ unsigned xb_add(unsigned* p, unsigned v) { return __hip_atomic_fetch_add(p, v, __ATOMIC_RELAXED, __HIP_MEMORY_SCOPE_AGENT); }
__device__ __forceinline__ unsigned xb_xcc_id() { return (unsigned)__builtin_amdgcn_s_getreg((3 << 11) | 20) & 0xFu; }
#define XB_SPIN(cond, bar) do { unsigned _sp = 0; while (cond) { __builtin_amdgcn_s_sleep(1); \
    if ((++_sp & 255u) == 0u) { if (xb_ld(&(bar)[XB_TMO])) break; if (_sp > XB_SPIN_CAP) { atomicAdd(&(bar)[XB_TMO], 1u); break; } } } } while (0)

struct XcdBarrier {
    unsigned* bar; unsigned x;
    volatile LAS unsigned* st;
};

__device__ __forceinline__ XcdBarrier xcd_barrier_post(unsigned* bar, volatile LAS unsigned* st) {
    XcdBarrier b; b.bar = bar; b.x = xb_xcc_id(); b.st = st;
    if (threadIdx.x == 0) (void)xb_add(&bar[XB_XCNT(b.x)], 1u);
    return b;
}
__device__ __forceinline__ void xcd_barrier_complete(unsigned* bar, unsigned x, unsigned& nloc, unsigned& nx) {
    const unsigned G = gridDim.x * gridDim.y * gridDim.z;
    unsigned sum, cnt, mine, sp = 0u;
    for (;;) {
        sum = 0u; cnt = 0u; mine = 0u;
#pragma unroll
        for (unsigned j = 0; j < 16; ++j) { const unsigned c = xb_ld(&bar[XB_XCNT(j)]); sum += c; cnt += (c > 0u) ? 1u : 0u; mine = (j == x) ? c : mine; }
        if (sum == G) break;
        __builtin_amdgcn_s_sleep(1);
        if ((++sp & 255u) == 0u) { if (xb_ld(&bar[XB_TMO])) break; if (sp > XB_SPIN_CAP) { atomicAdd(&bar[XB_TMO], 1u); break; } }
    }
    nloc = mine > 0u ? mine : 1u; nx = cnt > 0u ? cnt : 1u;
}

__device__ __forceinline__ void xcd_barrier(const XcdBarrier& b) {
    asm volatile("s_waitcnt vmcnt(0)" ::: "memory");
    __syncthreads();
    if (threadIdx.x == 0) {
        unsigned* bar = b.bar;
        __builtin_amdgcn_s_waitcnt(0);
        unsigned nloc = b.st[0], nx = b.st[1];
        if (nloc == 0u) { xcd_barrier_complete(bar, b.x, nloc, nx); b.st[0] = nloc; b.st[1] = nx; }
        const unsigned old = xb_add(&bar[XB_XSUB(b.x)], 1u);
        const unsigned gen = old / nloc;
        if (old + 1u == (gen + 1u) * nloc) {
            __builtin_amdgcn_fence(__ATOMIC_RELEASE, "agent");
            asm volatile("s_waitcnt vmcnt(0)" ::: "memory");
            const unsigned og = xb_add(&bar[XB_TOP], 1u);
            const unsigned tg = og / nx;
            if (og + 1u == (tg + 1u) * nx) xb_add(&bar[XB_TOPGEN], 1u);
            else XB_SPIN(xb_ld(&bar[XB_TOPGEN]) == tg, bar);
            __builtin_amdgcn_fence(__ATOMIC_ACQUIRE, "agent");
            xb_add(&bar[XB_XGEN(b.x)], 1u);
            asm volatile("s_waitcnt vmcnt(0)" ::: "memory");
        } else {
            XB_SPIN(xb_ld(&bar[XB_XGEN(b.x)]) == gen, bar);
            __builtin_amdgcn_fence(__ATOMIC_ACQUIRE, "agent");
            asm volatile("s_waitcnt vmcnt(0)" ::: "memory");
        }
    }
    __syncthreads();
}
constexpr int DEFER_SPLIT = 3340, DEFER_A = 800;
__device__ const unsigned char FOX_SCHED[12][2] = {{0x2f, 0x2}, {0x1f, 0x1}, {0x7, 0x0}, {0x2e, 0x18}, {0x1e, 0x3}, {0x2d, 0x19}, {0x1d, 0x4}, {0x6, 0x28}, {0x2c, 0x1a}, {0x1c, 0x29}, {0x2b, 0x5}, {0x1b, 0x2a}};
#ifndef REP_PRO
#define REP_PRO 1
#endif
#ifndef REP_G1
#define REP_G1 1
#endif
#ifndef REP_FOX
#define REP_FOX 1
#endif
#ifndef REP_ML
#define REP_ML 1
#endif
#ifndef REP_GDN
#define REP_GDN 1
#endif
#ifndef REP_G3
#define REP_G3 1
#endif
#ifndef REP_PREP
#define REP_PREP 1
#endif
constexpr int NWAVES = 8;
constexpr int DM = 2048, SEQ = 4096, NB = 2, M = NB * SEQ, DEPTH = 2, NIN = 7192, DFF = 5632;
constexpr int LDP = 7168, NPT = 7424;
constexpr int C_MQ = 0, C_MK = 512, C_MV = 1024, C_MO = 1536, C_FQ = 2048, C_FK = 3072, C_FV = 4096, C_GQ = 5120, C_GK = 5632, C_GV = 6144, C_GZ = 6656;
constexpr float NORM_EPS = 1e-6f, QK_SCALE = 0.08838834764831845f;
constexpr size_t MiB = 1u << 20;
constexpr size_t WS_CTL = 0, CTL_ZERO_BYTES = 64 * 1024;
constexpr size_t WL_WIN = 0, WL_WOUT = 29 * MiB, WL_WGU = 37 * MiB, WL_WDN = 81 * MiB, WL_STRIDE = 103 * MiB;
constexpr size_t WS_W = 1 * MiB;
constexpr size_t WS_H = 207 * MiB;
constexpr size_t OUT_HM = 0, OUT_HG = 16 * MiB;
constexpr size_t WS_P = 239 * MiB;
constexpr size_t WS_GR = 351 * MiB;
constexpr size_t WS_GEG = 352 * MiB;
constexpr size_t WS_FST = WS_GEG + 262144;
constexpr size_t WS_GEGM = WS_GEG + 4096, WS_DEN = WS_GEG + 65536;
constexpr size_t WM_GPK = 0, WM_GWV = 19 * MiB;
constexpr size_t WS_CN = 353 * MiB;
constexpr size_t WS_MB = WS_CN + 256 * 1024, WS_MM = WS_CN + 384 * 1024, WS_MC = WS_CN + 512 * 1024;
constexpr size_t WS_GPK = 354 * MiB;
constexpr size_t WS_GWV = 381 * MiB;
constexpr size_t WS_HF = 397 * MiB;
constexpr size_t WS_Y = 429 * MiB;
constexpr size_t WS_PRM = 461 * MiB;
constexpr size_t WS_SS = 462 * MiB;
constexpr size_t WS_END = 463 * MiB;
constexpr int PRM_STRIDE = 16384, PR_MIXN = 0, PR_FFNN = 2048, PR_CONV = 4096, PR_MNORM = 10240, PR_FNORM = 10752, PR_GNORM = 11776, PR_IB = 12288, PR_FB = 12292, PR_XB = 12296, PR_ALOG = 12304, PR_DT = 12308, PR_FINAL = 2 * PRM_STRIDE;
constexpr int CW_BAR = 4096, CW_FIN = 8192, CW_GATE = 12288;
constexpr int RING_OFF = 0, RING_BYTES = 131072;
constexpr int RSTD_OFF = 131072;
constexpr int LDSCTL_OFF = 139264, MISC_OFF = LDSCTL_OFF + 320;
constexpr int LDS_BYTES = 147456;
static_assert(WS_MM - WS_MB == 32768 * 4 && WS_MC - WS_MB == 65536 * 4 && C_FQ - C_FK == -1024 && C_FV - C_FK == 1024 && C_MQ - C_MK == -512 && C_MV - C_MK == 512 && C_MO - C_MK == 1024, "fox::Delta / CB offsets");
static_assert(RSTD_OFF + 5120 <= LDSCTL_OFF, "rstd scratch");
static_assert((M / 256) * (NPT / 256) / 8 == 4 * (NPT / 256) && (M / 256) * (2 * DFF / 256) / 8 == 4 * (2 * DFF / 256) && (M / 256) * (NPT / 256) % 8 == 0 && (M / 256) * (2 * DFF / 256) % 8 == 0, "StaticOrder: with grid % 8 == 0 every tile of workgroup c lies in row-panel group c % 8 (panel_rstd4)");
static_assert(fox::LDS_BYTES <= LDSCTL_OFF && RING_BYTES <= LDSCTL_OFF && MISC_OFF + 128 <= LDS_BYTES && gdn::PREP_LDS <= LDSCTL_OFF && gdn::SC_LDS <= LDSCTL_OFF && gdn::MS_LDS <= LDSCTL_OFF && 3 * gdn::MPK_BYTES <= LDSCTL_OFF && WM_GWV + 512 * (size_t)gdn::MWV_BYTES <= 29 * MiB && 512 * (size_t)gdn::MPK_BYTES <= WM_GWV, "lds map");

__device__ __forceinline__ float bf2f(bf16 v) { return __uint_as_float((unsigned)v << 16); }
__device__ __forceinline__ float bflo(unsigned u) { return __uint_as_float(u << 16); }
__device__ __forceinline__ float bfhi(unsigned u) { return __uint_as_float(u & 0xffff0000u); }
__device__ __forceinline__ int tid_l();
__device__ __forceinline__ float wave_sum(float v) {
#pragma unroll
    for (int o = 1; o < 64; o <<= 1) v += __shfl_xor(v, o);
    return v;
}
__device__ __forceinline__ float sigmoidf_(float x) { return 1.0f / (1.0f + expf(-x)); }
__device__ __forceinline__ float softplusf_(float x) { return fmaxf(x, 0.f) + log1pf(expf(-fabsf(x))); }
__device__ __forceinline__ float logsigmoidf_(float x) { return fminf(x, 0.f) - log1pf(expf(-fabsf(x))); }
__device__ __forceinline__ float softcapf_(float x) { return 15.0f * tanhf(x * (1.0f / 15.0f)); }

__device__ __forceinline__ void transpose_item(const float* W, int ldw, int scol, bf16* WT, int Kd, int drow, int k0, LAS unsigned char* scr, int lane, const float* sk = nullptr) {
    const int q = lane >> 4, c = lane & 15;
    const float* src = W + (size_t)(k0 + 16 * q) * ldw + scol + 4 * c;
    f32x4 v[16];
#pragma unroll
    for (int i = 0; i < 16; ++i) v[i] = __builtin_nontemporal_load((const f32x4*)(src + (size_t)i * ldw));
    if (sk) {
#pragma unroll
        for (int i4 = 0; i4 < 4; ++i4) { const f32x4 g = *(const f32x4*)(sk + k0 + 16 * q + 4 * i4);
            v[4 * i4] *= g[0]; v[4 * i4 + 1] *= g[1]; v[4 * i4 + 2] *= g[2]; v[4 * i4 + 3] *= g[3]; } }
#pragma unroll
    for (int j = 0; j < 4; ++j) {
        v4u o0, o1;
        o0.x = pk2(v[0][j], v[1][j]); o0.y = pk2(v[2][j], v[3][j]); o0.z = pk2(v[4][j], v[5][j]); o0.w = pk2(v[6][j], v[7][j]);
        o1.x = pk2(v[8][j], v[9][j]); o1.y = pk2(v[10][j], v[11][j]); o1.z = pk2(v[12][j], v[13][j]); o1.w = pk2(v[14][j], v[15][j]);
        LAS unsigned char* d = scr + (4 * c + j) * 144 + q * 32;
        *(LAS v4u*)d = o0; *(LAS v4u*)(d + 16) = o1; }
    LDS_WAIT(); asm volatile("" ::: "memory");
    const int nr = lane >> 3, kc = lane & 7;
#pragma unroll
    for (int j = 0; j < 8; ++j) { const v4u o = *(const LAS v4u*)(scr + (nr + 8 * j) * 144 + kc * 16);
        __builtin_nontemporal_store(o, (GAS v4u*)(WT + (size_t)(drow + nr + 8 * j) * Kd + k0 + 8 * kc)); }
    LDS_WAIT(); asm volatile("" ::: "memory");
}
template <int PART>
__device__ __forceinline__ void weights_phase(const float* w_in, const float* w_out, const float* w_gate, const float* w_up, const float* w_down,
                                              bf16* WIN, bf16* WOUT, bf16* WGU, bf16* WDN, LAS unsigned char* lds, int gw, int NGW, int wave, int lane, int gtid, int NGT, const float* nrm, int lo = 0, int hi = 1 << 30) {
    LAS unsigned char* scr = lds + RING_OFF + wave * 16384;
    constexpr int I_A = 32 * 32, I_B = 32 * 48, I_C = 32 * 32, I_O = 32 * 32, I_G = 32 * 88, I_U = 32 * 88, I_D = 88 * 32;
    if constexpr (PART == 0) {
        for (int it = gw; it < I_A + I_B + I_C + I_O; it += NGW) {
            int r = it;
            if (r < I_O) { const int kb = r % 32, nb = r / 32; transpose_item(w_out, DM, 64 * nb, WOUT, DM, 64 * nb, 64 * kb, scr, lane); continue; } r -= I_O;
            if (r < I_A) { const int kb = r % 32, nb = r / 32; transpose_item(w_in, NIN, 64 * nb, WIN, DM, 64 * nb, 64 * kb, scr, lane, nrm); continue; } r -= I_A;
            if (r < I_B) { const int kb = r % 32, nb = r / 32; transpose_item(w_in, NIN, 2056 + 64 * nb, WIN, DM, 2048 + 64 * nb, 64 * kb, scr, lane, nrm); continue; } r -= I_B;
            { const int kb = r % 32, nb = r / 32; transpose_item(w_in, NIN, 5136 + 64 * nb, WIN, DM, 5120 + 64 * nb, 64 * kb, scr, lane, nrm); }
        }
        for (int idx = gtid; idx < 256 * DM; idx += NGT) { const int r = idx / DM, k = idx % DM; float v = 0.f;
            if (r < 24) { const int sc = r < 8 ? 2048 + r : (r < 16 ? 5128 + (r - 8) : 7184 + (r - 16)); v = w_in[(size_t)k * NIN + sc] * nrm[k]; }
            WIN[(size_t)(7168 + r) * DM + k] = (bf16)f2bf(v); }
    } else {
        for (int it = lo + gw; it < (hi < I_O + I_G + I_U + I_D ? hi : I_O + I_G + I_U + I_D); it += NGW) {
            int r = it;
            if (r < I_O) { const int kb = r % 32, nb = r / 32; transpose_item(w_out, DM, 64 * nb, WOUT, DM, 64 * nb, 64 * kb, scr, lane); continue; } r -= I_O;
            if (r < I_G) { const int kb = r % 32, nb = r / 32; transpose_item(w_gate, DFF, 64 * nb, WGU, DM, 256 * (nb >> 1) + 64 * (nb & 1), 64 * kb, scr, lane, nrm); continue; } r -= I_G;
            if (r < I_U) { const int kb = r % 32, nb = r / 32; transpose_item(w_up, DFF, 64 * nb, WGU, DM, 256 * (nb >> 1) + 128 + 64 * (nb & 1), 64 * kb, scr, lane, nrm); continue; } r -= I_U;
            { const int kb = r % 88, nb = r / 88; transpose_item(w_down, DM, 64 * nb, WDN, DFF, 64 * nb, 64 * kb, scr, lane); }
        }
    }
}
__device__ __forceinline__ void rms_row_bf16(const float* xrow, bf16* orow, float* ssrow, int lane) {
    const f32x4* xr = (const f32x4*)xrow + lane;
    f32x4 v[8]; float s = 0.f;
#pragma unroll
    for (int j = 0; j < 8; ++j) { v[j] = xr[64 * j]; s += (v[j].x * v[j].x + v[j].y * v[j].y) + (v[j].z * v[j].z + v[j].w * v[j].w); }
    s = wave_sum(s);
    if (lane < 32) ssrow[lane] = (lane == 0) ? s : 0.f;
    unsigned long long* o8 = (unsigned long long*)orow + lane;
#pragma unroll
    for (int j = 0; j < 8; ++j) o8[64 * j] = (unsigned long long)pk2(v[j].x, v[j].y) | ((unsigned long long)pk2(v[j].z, v[j].w) << 32);
}
__device__ __forceinline__ void rms_row_f32(const bf16* xb, float* xrow, const float* w, const float* ssrow, int lane) {
    f32x4* xr = (f32x4*)xrow + lane; const f32x4* wr = (const f32x4*)w + lane;
    float s = 0.f;
#pragma unroll
    for (int i = 0; i < 32; ++i) s += ssrow[i];
    const float rstd = 1.0f / sqrtf(s * (1.0f / DM) + NORM_EPS);
#pragma unroll
    for (int j = 0; j < 8; ++j) { const unsigned long long q = ((const unsigned long long*)xb)[lane + 64 * j]; const unsigned q0 = (unsigned)q, q1 = (unsigned)(q >> 32);
        const f32x4 v = (f32x4){__uint_as_float(q0 << 16), __uint_as_float(q0 & 0xffff0000u), __uint_as_float(q1 << 16), __uint_as_float(q1 & 0xffff0000u)}, g = wr[64 * j];
        xr[64 * j] = (f32x4){v.x * rstd * g.x, v.y * rstd * g.y, v.z * rstd * g.z, v.w * rstd * g.w}; }
}
__device__ __forceinline__ float wave_incl_sum(float v, int lane) {
#pragma unroll
    for (int o = 1; o < 64; o <<= 1) { const float n = __shfl_up(v, o); if (lane >= o) v += n; }
    return v;
}
__device__ __forceinline__ float wave_incl_max(float v, int lane) {
#pragma unroll
    for (int o = 1; o < 64; o <<= 1) { const float n = __shfl_up(v, o); if (lane >= o) v = fmaxf(v, n); }
    return v;
}
__device__ __forceinline__ void fox_cumsum_block(int bh, const float* GR, const float* fox_bias, float* CN, LAS float* sc) {
    const int tl = tid_l(), lane = tl & 63, wave = __builtin_amdgcn_readfirstlane(tl >> 6);
    const int b = bh >> 3, h = bh & 7; const float bias = fox_bias[h];
    float raw[8];
#pragma unroll
    for (int k = 0; k < 8; ++k) raw[k] = GR[(b * SEQ + wave * 512 + k * 64 + lane) * 32 + 8 + h];
    float F[8]; float carry = 0.f;
#pragma unroll
    for (int k = 0; k < 8; ++k) { const float s = wave_incl_sum(logsigmoidf_(raw[k] + bias), lane); F[k] = carry + s; carry += __shfl(s, 63); }
    if (lane == 0) sc[wave] = carry;
    __syncthreads();
    float pre = 0.f;
#pragma unroll
    for (int w2 = 0; w2 < 8; ++w2) if (w2 < wave) pre += sc[w2];
#pragma unroll
    for (int k = 0; k < 8; ++k) CN[bh * SEQ + wave * 512 + k * 64 + lane] = -(pre + F[k]) * (1.0f / QK_SCALE);
    __syncthreads();
}
__device__ __forceinline__ void mlstm_scan_block(int bh, const float* GR, const float* ibias, const float* fbias, float* MB, float* MM, float* MC, LAS float* sc) {
    const int tl = tid_l(), lane = tl & 63, wave = __builtin_amdgcn_readfirstlane(tl >> 6);
    const int b = bh >> 2, h = bh & 3; const float ib = ibias[h], fb = fbias[h]; constexpr float L2E = 1.4426950408889634f;
    float ri[8], rf[8];
#pragma unroll
    for (int k = 0; k < 8; ++k) { const int row = (b * SEQ + wave * 512 + k * 64 + lane) * 32; ri[k] = GR[row + h]; rf[k] = GR[row + 4 + h]; }
    float F[8], B2[8], LM[8]; float carry = 0.f, cmax = -__builtin_inff();
#pragma unroll
    for (int k = 0; k < 8; ++k) { const float it = softcapf_(ri[k] + ib), lf = logsigmoidf_(softcapf_(rf[k] + fb));
        const float s = wave_incl_sum(lf, lane); F[k] = carry + s; carry += __shfl(s, 63);
        B2[k] = (it - F[k]) * L2E; const float mx = wave_incl_max(B2[k], lane); LM[k] = fmaxf(cmax, mx); cmax = fmaxf(cmax, __shfl(mx, 63)); }
    if (lane == 0) { sc[wave] = carry; sc[8 + wave] = cmax; }
    __syncthreads();
    float pre = 0.f, mprev = -__builtin_inff(), run = 0.f;
#pragma unroll
    for (int w2 = 0; w2 < 8; ++w2) if (w2 < wave) { mprev = fmaxf(mprev, sc[8 + w2] - run * L2E); run += sc[w2]; }
    pre = run;
#pragma unroll
    for (int k = 0; k < 8; ++k) { const int o = bh * SEQ + wave * 512 + k * 64 + lane;
        const float b2 = B2[k] - pre * L2E, m2 = fmaxf(mprev, LM[k] - pre * L2E), Fg = pre + F[k];
        MB[o] = b2; MM[o] = m2; MC[o] = exp2f(-(Fg * L2E + m2)); }
    __syncthreads();
}
__device__ __forceinline__ float half_sum(float v) { v += __shfl_xor(v, 1); v += __shfl_xor(v, 2); v += __shfl_xor(v, 4); v += __shfl_xor(v, 8); v += __shfl_xor(v, 16); return v; }
__device__ __forceinline__ float fsig(float x) { return __builtin_amdgcn_rcpf(1.0f + __expf(-x)); }
struct PostLd { f32x4 oa[4], ob[4]; float wa[4], wb[4]; f32x4 v[4]; unsigned long long gt[4]; float dn[2], mc[2]; };
__device__ __forceinline__ void post_load(int m, const bf16* P, const float* HM, const float* HG, const float* DEN, const float* MC, const float* PO, const float* FST, int lane, PostLd& r) {
    const bf16* pr = P + (size_t)m * LDP;
    if ((m & 4095) >= 2048) {
        const int b = m >> 12, tr = (m & 4095) - 2048; constexpr float C2 = 1.4426950408889634f * QK_SCALE;
        const size_t ra = ((size_t)(0 * 2 + b) * 2048 + tr), rb = ((size_t)(1 * 2 + b) * 2048 + tr);
#pragma unroll
        for (int j = 0; j < 4; ++j) { const int head = 2 * j + (lane >> 5);
            r.oa[j] = *(const f32x4*)(PO + ra * 1024 + 256 * j + 4 * lane); r.ob[j] = *(const f32x4*)(PO + rb * 1024 + 256 * j + 4 * lane);
            const float ma = FST[(ra * 8 + head) * 2], la = FST[(ra * 8 + head) * 2 + 1], mb = FST[(rb * 8 + head) * 2], lb = FST[(rb * 8 + head) * 2 + 1];
            const float mx = fmaxf(ma, mb); r.wa[j] = la * __builtin_amdgcn_exp2f((ma - mx) * C2); r.wb[j] = lb * __builtin_amdgcn_exp2f((mb - mx) * C2); }
    }
#pragma unroll
    for (int j = 0; j < 2; ++j) { { const unsigned long long q = *(const unsigned long long*)((const bf16*)HM + (size_t)m * 512 + 256 * j + 4 * lane); r.v[j] = (f32x4){bflo((unsigned)q), bfhi((unsigned)q), bflo((unsigned)(q >> 32)), bfhi((unsigned)(q >> 32))}; }
        r.gt[j] = *(const unsigned long long*)(pr + C_MO + 256 * j + 4 * lane);
        { const unsigned long long q = *(const unsigned long long*)((const bf16*)HG + (size_t)m * 512 + 256 * j + 4 * lane); r.v[2 + j] = (f32x4){bflo((unsigned)q), bfhi((unsigned)q), bflo((unsigned)(q >> 32)), bfhi((unsigned)(q >> 32))}; }
        r.gt[2 + j] = *(const unsigned long long*)(pr + C_GZ + 256 * j + 4 * lane);
        const int head = 2 * j + (lane >> 5); r.dn[j] = DEN[(size_t)m * 4 + head]; r.mc[j] = MC[((size_t)(m >> 12) * 4 + head) * SEQ + (m & 4095)]; }
}
__device__ __forceinline__ void post_finish(int m, const PostLd& r, bf16* Y, const f32x4 (&wq)[4], const f32x4 (&w)[4], int lane) {
    unsigned long long* yr = (unsigned long long*)(Y + (size_t)m * DM) + lane;
    if ((m & 4095) >= 2048) {
#pragma unroll
        for (int j = 0; j < 4; ++j) { const float inv = __builtin_amdgcn_rcpf(r.wa[j] + r.wb[j]); const f32x4 x = (r.oa[j] * r.wa[j] + r.ob[j] * r.wb[j]) * inv;
            const float rstd = 1.0f / sqrtf(half_sum((x[0] * x[0] + x[1] * x[1]) + (x[2] * x[2] + x[3] * x[3])) * (1.0f / 128.0f) + NORM_EPS);
            yr[128 + 64 * j] = (unsigned long long)pk2(x[0] * rstd * wq[j][0], x[1] * rstd * wq[j][1]) | ((unsigned long long)pk2(x[2] * rstd * wq[j][2], x[3] * rstd * wq[j][3]) << 32); }
    }
#pragma unroll
    for (int j = 0; j < 4; ++j) { f32x4 x = r.v[j]; float o0, o1, o2, o3; const unsigned g0 = (unsigned)r.gt[j], g1 = (unsigned)(r.gt[j] >> 32);
        if (j < 2) {
            x = x * __builtin_amdgcn_rcpf(fmaxf(fabsf(r.dn[j]), r.mc[j]));
            const float mean = half_sum((x[0] + x[1]) + (x[2] + x[3])) * (1.0f / 128.0f); x = x - mean;
            const float rstd = 1.0f / sqrtf(half_sum((x[0] * x[0] + x[1] * x[1]) + (x[2] * x[2] + x[3] * x[3])) * (1.0f / 128.0f) + NORM_EPS);
            o0 = x[0] * rstd * w[j][0] * fsig(bflo(g0)); o1 = x[1] * rstd * w[j][1] * fsig(bfhi(g0)); o2 = x[2] * rstd * w[j][2] * fsig(bflo(g1)); o3 = x[3] * rstd * w[j][3] * fsig(bfhi(g1));
        } else { const float rstd = 1.0f / sqrtf(half_sum((x[0] * x[0] + x[1] * x[1]) + (x[2] * x[2] + x[3] * x[3])) * (1.0f / 128.0f) + NORM_EPS);
            const float z0 = bflo(g0), z1 = bfhi(g0), z2 = bflo(g1), z3 = bfhi(g1);
            o0 = x[0] * rstd * w[j][0] * z0 * fsig(z0); o1 = x[1] * rstd * w[j][1] * z1 * fsig(z1); o2 = x[2] * rstd * w[j][2] * z2 * fsig(z2); o3 = x[3] * rstd * w[j][3] * z3 * fsig(z3); }
        yr[(j < 2 ? 64 * j : 384 + 64 * (j - 2))] = (unsigned long long)pk2(o0, o1) | ((unsigned long long)pk2(o2, o3) << 32); }
}

__device__ __forceinline__ GAS unsigned char* launder(unsigned char* p) { GAS unsigned char* g = (GAS unsigned char*)p; asm volatile("" : "+s"(g)); return g; }
__device__ __forceinline__ int tid_l() { int t = threadIdx.x; asm volatile("" : "+v"(t)); return t; }
__device__ __forceinline__ void copy_f32(const float* src, float* dst, int n, int gtid, int NGT) { for (int i = gtid; i < n; i += NGT) dst[i] = src[i]; }
struct Args { const float* in[18]; float* out; unsigned char* ws; };

template <int L>
__device__ __forceinline__ void layer_body(unsigned char* ws_, const float* xin, float* X, const XcdBarrier& bar, unsigned char* lds,
                                           const float* w_out, const float* w_gate, const float* w_up, const float* w_down, const float* w_in_next, const float* nffn, const float* nmix_next) {
    LAS unsigned char* ldsl = (LAS unsigned char*)lds;
#ifndef NO_PH1
    for (int rep_ = 0; rep_ < REP_G1; ++rep_)
    { GAS unsigned char* w = launder(ws_);
      pg8::Gemm g{(const bf16*)(w + WS_H), (const bf16*)(w + WS_W + L * WL_STRIDE + WL_WIN), M, NPT, DM}; pg8::StaticOrder S; S.init(M, NPT, gridDim.x, blockIdx.x, 4, 28);
      pg8::panel_rstd4((const float*)(w + WS_SS), blockIdx.x & 7, (LAS float*)(ldsl + RSTD_OFF));
      pg8::EpiProj E{(bf16*)(w + WS_P), (float*)(w + WS_GR), (const float*)(w + WS_SS), (LAS float*)(ldsl + RSTD_OFF), (unsigned*)(w + WS_CTL) + CW_GATE + 64 * L, (int)(blockIdx.x & 7)};
      pg8::gemm_phase<pg8::EpiProj, pg8::StaticOrder, true, true>(ldsl + RING_OFF, g, S, E);
      if (blockIdx.x >= 160 && blockIdx.x < 184) {
        unsigned* gc = (unsigned*)(w + WS_CTL) + CW_GATE + 64 * L; unsigned* tmo = (unsigned*)(w + WS_CTL) + CW_BAR + XB_TMO;
        if (threadIdx.x == 0) { unsigned sp = 0;
          while (__hip_atomic_load(gc, __ATOMIC_RELAXED, __HIP_MEMORY_SCOPE_AGENT) < 32u) { __builtin_amdgcn_s_sleep(1);
            if ((++sp & 255u) == 0u) { if (__hip_atomic_load(tmo, __ATOMIC_RELAXED, __HIP_MEMORY_SCOPE_AGENT)) break; if (sp > (1u << 18)) { atomicAdd(tmo, 1u); break; } } }
          __builtin_amdgcn_fence(__ATOMIC_ACQUIRE, "agent"); asm volatile("s_waitcnt vmcnt(0)" ::: "memory"); }
        __syncthreads();
        const float* prm = (const float*)(w + WS_PRM) + L * PRM_STRIDE; const float* GR = (const float*)(w + WS_GR); const int sb = blockIdx.x - 160;
        if (sb < 16) fox_cumsum_block(sb, GR, prm + PR_XB, (float*)(w + WS_CN), (LAS float*)(ldsl + RSTD_OFF));
        else mlstm_scan_block(sb - 16, GR, prm + PR_IB, prm + PR_FB, (float*)(w + WS_MB), (float*)(w + WS_MM), (float*)(w + WS_MC), (LAS float*)(ldsl + RSTD_OFF));
        __syncthreads(); }
      if (blockIdx.x >= 160) {
        const int tid = tid_l(), lane = tid & 63, wave = __builtin_amdgcn_readfirstlane(tid >> 6); unsigned char* wl = ws_ + WS_W + L * WL_STRIDE;
        if (blockIdx.x >= 184)
          weights_phase<1>(nullptr, w_out, w_gate, w_up, w_down, nullptr, (bf16*)(wl + WL_WOUT), (bf16*)(wl + WL_WGU), (bf16*)(wl + WL_WDN), ldsl,
                           (blockIdx.x - 184) * NWAVES + wave, ((int)gridDim.x - 184) * NWAVES, wave, lane, 0, 1, nffn, 1024, 1024 + DEFER_A);
        weights_phase<1>(nullptr, w_out, w_gate, w_up, w_down, nullptr, (bf16*)(wl + WL_WOUT), (bf16*)(wl + WL_WGU), (bf16*)(wl + WL_WDN), ldsl,
                         (blockIdx.x - 160) * NWAVES + wave, ((int)gridDim.x - 160) * NWAVES, wave, lane, 0, 1, nffn, 1024 + DEFER_A, 1024 + DEFER_SPLIT); } }
#endif
    xcd_barrier(bar);
#ifndef NO_PH2
    for (int rep_ = 0; rep_ < REP_PREP; ++rep_)
    { GAS unsigned char* w = launder(ws_); const int tl = tid_l(), lane = tl & 63, gw = blockIdx.x * NWAVES + (tl >> 6);
      const float* prm = (const float*)(w + WS_PRM) + L * PRM_STRIDE; const float* GR = (const float*)(w + WS_GR);
      for (int u = blockIdx.x; u < 512; u += gridDim.x)
          gdn::prep_unit(u, (const bf16*)(w + WS_P), GR, prm + PR_CONV, prm + PR_ALOG, prm + PR_DT, (unsigned char*)(w + WS_GPK), (float*)(w + WS_GWV), (float*)(w + WS_GEG), (char*)lds); }
#endif
    { GAS unsigned char* w = launder(ws_); unsigned char* wm = (unsigned char*)(w + WS_W + L * WL_STRIDE + WL_WIN);
      for (int u = blockIdx.x; u < 512; u += gridDim.x)
          gdn::mlstm_prep_unit(u, (const bf16*)(w + WS_P), (const float*)(w + WS_MB), (const float*)(w + WS_MM), wm + WM_GPK, wm + WM_GWV, (float*)(w + WS_GEGM), (char*)lds); }
    xcd_barrier(bar);
    { const int bx = blockIdx.x;
#ifndef NO_FOX
      if (bx < 192) for (int rep_ = 0; rep_ < REP_FOX; ++rep_) {
        GAS unsigned char* w = launder(ws_); const bf16* P = (const bf16*)(w + WS_P);
        const int kk = bx >> 3, bh = (bx & 7) + 8 * (kk / 12), k12 = kk % 12, b = bh >> 3, h = bh & 7;
        for (int pass = 0; pass < 2; ++pass) { const int code = FOX_SCHED[k12][pass], qb = code & 15, part = code >> 4, ntall = 4 * (qb + 1);
            fox::BlockRef r;
            r.K = P + (size_t)b * SEQ * LDP + C_FK + h * 128; r.CB = (const float*)(w + WS_CN) + (size_t)bh * SEQ;
            r.Y = (bf16*)(w + WS_Y) + (size_t)b * SEQ * DM + 512 + h * 128; r.NW = (const float*)(w + WS_PRM) + L * PRM_STRIDE + PR_FNORM + h * 128; r.P0 = qb * 256;
            r.t0 = (part == 2) ? ntall / 2 : 0; r.nt = (part == 0) ? ntall : ntall / 2;
            r.PO = part ? (float*)(w + WS_HF) + ((size_t)((part - 1) * 2 + b) * 2048) * 1024 + h * 128 : (float*)nullptr;
            r.ST = (float*)(w + WS_FST) + ((size_t)((part - 1 < 0 ? 0 : part - 1) * 2 + b) * 2048 * 8 + h) * 2;
            fox::Seam S; fox::prime<false>(r, (char*)lds, S); fox::block<false>(r, (char*)lds, S); }
      }
#endif
#ifndef NO_ML
      if ((bx >= 192 && bx < 200) || (bx >= 216 && bx < 224)) {
        GAS unsigned char* w = launder(ws_); unsigned char* wm = (unsigned char*)(w + WS_W + L * WL_STRIDE + WL_WIN);
        gdn::mscan2_unit(bx & 7, bx >= 216 ? 1 : 0, wm + WM_GPK, wm + WM_GWV, (const float*)(w + WS_GEGM), (float*)((unsigned char*)X + OUT_HM), (float*)(w + WS_DEN), (char*)lds); }
#endif
      if (bx >= 224) {
        const int tid = tid_l(), lane = tid & 63, wave = __builtin_amdgcn_readfirstlane(tid >> 6); unsigned char* wl = ws_ + WS_W + L * WL_STRIDE;
        weights_phase<1>(nullptr, w_out, w_gate, w_up, w_down, nullptr, (bf16*)(wl + WL_WOUT), (bf16*)(wl + WL_WGU), (bf16*)(wl + WL_WDN), ldsl,
                         (bx - 224) * NWAVES + wave, ((int)gridDim.x - 224) * NWAVES, wave, lane, 0, 1, nffn, 1024 + DEFER_SPLIT); }
#ifndef NO_GDN
      if (bx >= 200 && bx < 216) for (int rep_ = 0; rep_ < REP_GDN; ++rep_) { GAS unsigned char* w = launder(ws_);
        gdn::scan_unit((bx - 200) & 7, (bx - 200) >> 3, (const unsigned char*)(w + WS_GPK), (const float*)(w + WS_GWV), (const float*)(w + WS_GEG), (float*)((unsigned char*)X + OUT_HG), (char*)lds); }
#endif
    }
    xcd_barrier(bar);
#ifndef NO_PH4
    { GAS unsigned char* w = launder(ws_); const int tl = tid_l(), lane = tl & 63, gw = blockIdx.x * NWAVES + (tl >> 6), NGW = gridDim.x * NWAVES;
      const float* prm = (const float*)(w + WS_PRM) + L * PRM_STRIDE;
      const bf16* Pp = (const bf16*)(w + WS_P); const float* HMp = (const float*)((const unsigned char*)X + OUT_HM); const float* HGp = (const float*)((const unsigned char*)X + OUT_HG);
      const float* DENp = (const float*)(w + WS_DEN); const float* MCp = (const float*)(w + WS_MC); const float* POp = (const float*)(w + WS_HF); const float* FSTp = (const float*)(w + WS_FST); bf16* Yp = (bf16*)(w + WS_Y);
      f32x4 wq[4], wn[4];
#pragma unroll
      for (int j = 0; j < 4; ++j) { wq[j] = *(const f32x4*)(prm + PR_FNORM + 256 * j + 4 * lane); wn[j] = (j < 2) ? *(const f32x4*)(prm + PR_MNORM + 256 * j + 4 * lane) : *(const f32x4*)(prm + PR_GNORM + 256 * (j - 2) + 4 * lane); }
      for (int m = gw; m < M; m += 2 * NGW) { const int m1 = m + NGW;
          PostLd r0, r1; post_load(m, Pp, HMp, HGp, DENp, MCp, POp, FSTp, lane, r0); if (m1 < M) post_load(m1, Pp, HMp, HGp, DENp, MCp, POp, FSTp, lane, r1);
          post_finish(m, r0, Yp, wq, wn, lane); if (m1 < M) post_finish(m1, r1, Yp, wq, wn, lane); } }
#endif
    xcd_barrier(bar);
#ifndef NO_PH5
    { GAS unsigned char* w = launder(ws_);
      pg8::Gemm g{(const bf16*)(w + WS_Y), (const bf16*)(w + WS_W + L * WL_STRIDE + WL_WOUT), M, DM, DM}; pg8::StaticOrder S; S.init(M, DM, gridDim.x, blockIdx.x); pg8::EpiRes<L == 0> E{(L == 0) ? (const void*)xin : (const void*)(w + WS_H), (bf16*)(w + WS_H), (float*)(w + WS_SS)};
      pg8::gemm_phase<pg8::EpiRes<L == 0>, pg8::StaticOrder, true, true>(ldsl + RING_OFF, g, S, E); }
#endif
    xcd_barrier(bar);
#ifndef NO_PH7
    for (int rep_ = 0; rep_ < REP_G3; ++rep_)
    { GAS unsigned char* w = launder(ws_);
      pg8::Gemm g{(const bf16*)(w + WS_H), (const bf16*)(w + WS_W + L * WL_STRIDE + WL_WGU), M, 2 * DFF, DM}; pg8::StaticOrder S; S.init(M, 2 * DFF, gridDim.x, blockIdx.x);
      pg8::panel_rstd4((const float*)(w + WS_SS), blockIdx.x & 7, (LAS float*)(ldsl + RSTD_OFF)); pg8::EpiSwiglu E{(bf16*)(w + WS_P), (const float*)(w + WS_SS), (LAS float*)(ldsl + RSTD_OFF), (int)(blockIdx.x & 7)};
      pg8::gemm_phase<pg8::EpiSwiglu, pg8::StaticOrder, true, true>(ldsl + RING_OFF, g, S, E);
      if (L + 1 < DEPTH && blockIdx.x >= 128) {
        const int tid = tid_l(), lane = tid & 63, wave = __builtin_amdgcn_readfirstlane(tid >> 6); unsigned char* wl = ws_ + WS_W + (L + 1) * WL_STRIDE;
        const int gwq = (blockIdx.x - 128) * NWAVES + wave, nwq = ((int)gridDim.x - 128) * NWAVES;
        weights_phase<0>(w_in_next, w_out + (size_t)DM * DM, nullptr, nullptr, nullptr, (bf16*)(wl + WL_WIN), (bf16*)(wl + WL_WOUT), nullptr, nullptr, ldsl,
                         gwq, nwq, wave, lane, gwq * 64 + lane, nwq * 64, nmix_next); } }
#endif
    xcd_barrier(bar);
#ifndef NO_PH8
    { GAS unsigned char* w = launder(ws_);
      pg8::Gemm g{(const bf16*)(w + WS_P), (const bf16*)(w + WS_W + L * WL_STRIDE + WL_WDN), M, DM, DFF}; pg8::StaticOrder S; S.init(M, DM, gridDim.x, blockIdx.x); pg8::EpiRes<false> E{(const void*)(w + WS_H), (bf16*)(w + WS_H), (float*)(w + WS_SS)};
      if (L + 1 == DEPTH && gridDim.x >= 256) {
        pg8::EpiFinal F{(const bf16*)(w + WS_H), X, (const float*)(w + WS_PRM) + PR_FINAL, (float*)(w + WS_SS), (unsigned*)(w + WS_CTL) + CW_FIN, (unsigned*)(w + WS_CTL) + CW_BAR + XB_TMO, (LAS float*)(ldsl + RSTD_OFF)};
        pg8::gemm_phase<pg8::EpiFinal, pg8::StaticOrder, true, true>(ldsl + RING_OFF, g, S, F); return; }
      pg8::gemm_phase<pg8::EpiRes<false>, pg8::StaticOrder, true, true>(ldsl + RING_OFF, g, S, E); }
#endif
    xcd_barrier(bar);
}

__global__ void __launch_bounds__(NWAVES * 64, 2) hybrid_fwd(Args args) {
    extern __shared__ __attribute__((aligned(16))) unsigned char lds[];
    LAS unsigned char* ldsl = (LAS unsigned char*)lds;
    volatile LAS unsigned* MISC = (volatile LAS unsigned*)(ldsl + MISC_OFF);
    unsigned char* ws = args.ws;
    for (int u = threadIdx.x; u < (LDS_BYTES - LDSCTL_OFF) / 4; u += NWAVES * 64) ((LAS unsigned*)(ldsl + LDSCTL_OFF))[u] = 0u;
    __syncthreads();
    XcdBarrier bar = xcd_barrier_post((unsigned*)(ws + WS_CTL) + CW_BAR, MISC + 8);
#ifndef NO_PRO
    for (int rep_ = 0; rep_ < REP_PRO; ++rep_)
    { const int tid = tid_l(), lane = tid & 63, wave = __builtin_amdgcn_readfirstlane(tid >> 6);
      const int gw = blockIdx.x * NWAVES + wave, NGW = gridDim.x * NWAVES, gtid = blockIdx.x * (NWAVES * 64) + tid, NGT = gridDim.x * NWAVES * 64;
      { unsigned char* wl = ws + WS_W;
        weights_phase<0>(args.in[2], args.in[12], nullptr, nullptr, nullptr, (bf16*)(wl + WL_WIN), (bf16*)(wl + WL_WOUT), nullptr, nullptr, ldsl, gw, NGW, wave, lane, gtid, NGT, args.in[1]); }
#pragma unroll
      for (int l = 0; l < DEPTH; ++l) {
        float* prm = (float*)(ws + WS_PRM) + l * PRM_STRIDE;
        copy_f32(args.in[1] + l * DM, prm + PR_MIXN, DM, gtid, NGT); copy_f32(args.in[13] + l * DM, prm + PR_FFNN, DM, gtid, NGT);
        copy_f32(args.in[6] + l * 6144, prm + PR_CONV, 6144, gtid, NGT); copy_f32(args.in[9] + l * 512, prm + PR_MNORM, 512, gtid, NGT);
        copy_f32(args.in[10] + l * 1024, prm + PR_FNORM, 1024, gtid, NGT); copy_f32(args.in[11] + l * 512, prm + PR_GNORM, 512, gtid, NGT);
        copy_f32(args.in[3] + l * 4, prm + PR_IB, 4, gtid, NGT); copy_f32(args.in[4] + l * 4, prm + PR_FB, 4, gtid, NGT); copy_f32(args.in[5] + l * 8, prm + PR_XB, 8, gtid, NGT);
        copy_f32(args.in[7] + l * 4, prm + PR_ALOG, 4, gtid, NGT); copy_f32(args.in[8] + l * 4, prm + PR_DT, 4, gtid, NGT);
      }
      copy_f32(args.in[17], (float*)(ws + WS_PRM) + PR_FINAL, DM, gtid, NGT);
      for (int m = gw; m < M; m += NGW) rms_row_bf16(args.in[0] + (size_t)m * DM, (bf16*)(ws + WS_H) + (size_t)m * DM, (float*)(ws + WS_SS) + (size_t)m * 32, lane); }
#endif
    xcd_barrier(bar);
    layer_body<0>(ws, args.in[0], args.out, bar, lds, args.in[12], args.in[14], args.in[15], args.in[16], args.in[2] + (size_t)DM * NIN, args.in[13], args.in[1] + DM);
    layer_body<1>(ws, args.out, args.out, bar, lds, args.in[12] + (size_t)DM * DM, args.in[14] + (size_t)DM * DFF, args.in[15] + (size_t)DM * DFF, args.in[16] + (size_t)DFF * DM, nullptr, args.in[13] + DM, nullptr);
    if (gridDim.x < 256)
    { GAS unsigned char* w = launder(ws); const int tl = tid_l(), lane = tl & 63, gw = blockIdx.x * NWAVES + (tl >> 6), NGW = gridDim.x * NWAVES;
      const float* prm = (const float*)(w + WS_PRM) + PR_FINAL; float* X = args.out;
      for (int m = gw; m < M; m += NGW) rms_row_f32((const bf16*)(w + WS_H) + (size_t)m * DM, X + (size_t)m * DM, prm, (const float*)(w + WS_SS) + (size_t)m * 32, lane); }
}

extern "C" void kernel_launch(void* const* d_in, const int* in_sizes, int n_in, void* d_out, int out_size, void* d_ws, size_t ws_size, hipStream_t stream) {
    static int grid = 0;
    if (grid == 0) {
        if (n_in != 18 || in_sizes[0] != M * DM || out_size != M * DM || ws_size < WS_END) {
            fprintf(stderr, "kernel_launch: unexpected shapes: n_in %d in0 %d out %d ws %zu (need >= %zu)\n", n_in, n_in > 0 ? in_sizes[0] : -1, out_size, ws_size, (size_t)WS_END); grid = -1; return; }
        int dev = 0, cus = 0, per_cu = 0;
        if (hipGetDevice(&dev) != hipSuccess || hipDeviceGetAttribute(&cus, hipDeviceAttributeMultiprocessorCount, dev) != hipSuccess) { grid = -1; return; }
        if (hipFuncSetAttribute((const void*)hybrid_fwd, hipFuncAttributeMaxDynamicSharedMemorySize, LDS_BYTES) != hipSuccess) { fprintf(stderr, "kernel_launch: hipFuncSetAttribute failed\n"); grid = -1; return; }
        if (hipOccupancyMaxActiveBlocksPerMultiprocessor(&per_cu, (const void*)hybrid_fwd, NWAVES * 64, LDS_BYTES) != hipSuccess || per_cu < 1) {
            fprintf(stderr, "kernel_launch: occupancy query says %d blocks per CU\n", per_cu); (void)hipGetLastError(); grid = -1; return; }
        grid = cus;
        if (grid < 232 || grid % 8 != 0) { fprintf(stderr, "kernel_launch: unsupported CU count %d\n", cus); grid = -1; return; }
    }
    if (grid < 0) return;
    if (hipMemsetAsync((char*)d_ws + WS_CTL, 0, CTL_ZERO_BYTES, stream) != hipSuccess) return;
    Args a{};
    for (int i = 0; i < 18; ++i) a.in[i] = (const float*)d_in[i];
    a.out = (float*)d_out; a.ws = (unsigned char*)d_ws;
    hipLaunchKernelGGL(hybrid_fwd, dim3(grid), dim3(NWAVES * 64), LDS_BYTES, stream, a);
}
```

```cpp
#include <hip/hip_runtime.h>
#include <cstdio>
#include <cstdint>
namespace pg8 {
#define PG8_LAS __attribute__((address_space(3)))
typedef unsigned short bf16_t;
typedef short bf16x8 __attribute__((ext_vector_type(8)));
typedef float f32x4 __attribute__((ext_vector_type(4)));
typedef unsigned u32x4 __attribute__((ext_vector_type(4)));
constexpr int BM = 256, BK = 64, HALF = 128, HTB = HALF * BK * 2  , STAGE_BYTES = 8 * HTB, NXCD = 8;

__host__ __device__ __forceinline__ int lds_byte(int r, int c) { const int st = (r >> 4) * 2 + (c >> 5), rr = r & 15, cc = c & 31, ob = rr * 64 + cc * 2; return st * 1024 + (ob ^ (((ob >> 9) & 1) << 5)); }
__host__ __device__ __forceinline__ void stage_rc(int b, int& R, int& C) { const int st = b / 1024, sb = b % 1024, swz = sb ^ (((sb >> 9) & 1) << 5); R = (st >> 1) * 16 + swz / 64; C = (st & 1) * 32 + (swz % 64) / 2; }
__host__ __device__ __forceinline__ int perm32(int rho) { const int n = rho >> 4, i = rho & 15; return 8 * (i >> 2) + 4 * n + (i & 3); }

struct Unit { int pm, pn; };
struct Gemm { const bf16_t* A; const bf16_t* Bt; int M, N, K; };

struct StaticOrder {
    int nM, nN, nwg, G, c, WGM, rot;
    __host__ __device__ void init(int M, int N, int G_, int c_, int wgm = 4, int rot_ = 0) { nM = M / BM; nN = N / BM; nwg = nM * nN; G = G_; c = c_; WGM = wgm; rot = rot_; }
    __host__ __device__ bool next(int i, Unit& u) const {
        const long L = (long)i * G + c; if (L >= nwg) return false;
        int wgid = (int)L; { const int q = nwg / NXCD, r = nwg % NXCD, xcd = wgid % NXCD, off = wgid / NXCD; wgid = (xcd < r ? xcd * (q + 1) : r * (q + 1) + (xcd - r) * q) + off; }
        const int nig = WGM * nN, gid = wgid / nig, fm = gid * WGM, gsz = (nM - fm) < WGM ? (nM - fm) : WGM;
        u.pm = fm + ((wgid % nig) % gsz); u.pn = ((wgid % nig) / gsz + rot) % nN; return true;
    }
    __device__ __forceinline__ void a_ready(const Unit&) const {}
    __device__ __forceinline__ void done(const Unit&) const {}
};

__device__ __forceinline__ unsigned cvt_pk_bf16(float lo, float hi) { unsigned r; asm volatile("v_cvt_pk_bf16_f32 %0, %1, %2" : "=v"(r) : "v"(lo), "v"(hi)); return r; }
typedef float f32x2 __attribute__((ext_vector_type(2)));
__device__ __forceinline__ void row_rstd(const float* SS, int pm, PG8_LAS float* rl) {
    const int t = threadIdx.x;
    if (t < 256) { const f32x4* p = (const f32x4*)(SS + (size_t)(pm * BM + t) * 32); f32x4 s = p[0];
#pragma unroll
        for (int i = 1; i < 8; ++i) s += p[i];
        rl[t] = 1.0f / sqrtf(((s[0] + s[1]) + (s[2] + s[3])) * (1.0f / 2048.0f) + 1e-6f); }
    asm volatile("s_waitcnt lgkmcnt(0)" ::: "memory"); __builtin_amdgcn_s_barrier(); asm volatile("" ::: "memory");
}
__device__ __forceinline__ void panel_rstd4(const float* SS, int grp, PG8_LAS float* rl4) {
    int t = threadIdx.x; asm volatile("" : "+v"(t));
#pragma unroll
    for (int h = 0; h < 2; ++h) { const int r = t + 512 * h; const f32x4* p = (const f32x4*)(SS + (size_t)(grp * 1024 + r) * 32); f32x4 s = p[0];
#pragma unroll
        for (int i = 1; i < 8; ++i) s += p[i];
        rl4[r] = 1.0f / sqrtf(((s[0] + s[1]) + (s[2] + s[3])) * (1.0f / 2048.0f) + 1e-6f); }
    __syncthreads();
}
__device__ __forceinline__ PG8_LAS float* tile_rstd(int pm, PG8_LAS float* rl4) { return rl4 + (pm & 3) * 256; }
struct EpiProj {
    static constexpr bool PERM = true, AFTER_DRAIN = false;
    bf16_t* P; float* GR; const float* SS; PG8_LAS float* rl4; unsigned* gcnt; int grp;
    __device__ __forceinline__ void operator()(const f32x4 (&acc)[2][2][4][2], const Unit& u, int wr, int wc, int fr, int fq) const {
        PG8_LAS float* rl = tile_rstd(u.pm, rl4);
        const int row0 = u.pm * BM + wr * 64 + fr, rloc = wr * 64 + fr;
        if (u.pn < 28) {
            const int col0 = u.pn * BM + wc * 32 + 8 * fq;
#pragma unroll
            for (int ai = 0; ai < 2; ++ai)
#pragma unroll
                for (int m = 0; m < 4; ++m) { bf16_t* rowp = P + (size_t)(row0 + ai * HALF + m * 16) * 7168 + col0; const float rs = rl[rloc + ai * HALF + m * 16];
#pragma unroll
                    for (int bj = 0; bj < 2; ++bj) { const f32x4 v0 = acc[ai][bj][m][0] * rs, v1 = acc[ai][bj][m][1] * rs;
                        u32x4 w; w.x = cvt_pk_bf16(v0[0], v0[1]); w.y = cvt_pk_bf16(v0[2], v0[3]); w.z = cvt_pk_bf16(v1[0], v1[1]); w.w = cvt_pk_bf16(v1[2], v1[3]);
                        *(u32x4*)(rowp + bj * HALF) = w; } }
        } else if (wc == 0) {
#pragma unroll
            for (int ai = 0; ai < 2; ++ai)
#pragma unroll
                for (int m = 0; m < 4; ++m) { float* g = GR + (size_t)(row0 + ai * HALF + m * 16) * 32 + 8 * fq; const float rs = rl[rloc + ai * HALF + m * 16];
                    *(f32x4*)g = acc[ai][0][m][0] * rs; *(f32x4*)(g + 4) = acc[ai][0][m][1] * rs; }
        }
        if (u.pn == 28) {
            asm volatile("s_waitcnt vmcnt(0)" ::: "memory"); __syncthreads();
            if (threadIdx.x == 0) { __builtin_amdgcn_fence(__ATOMIC_RELEASE, "agent"); asm volatile("s_waitcnt vmcnt(0)" ::: "memory"); (void)__hip_atomic_fetch_add(gcnt, 1u, __ATOMIC_RELAXED, __HIP_MEMORY_SCOPE_AGENT); } }
    }
};
template <bool BASE_F32>
struct EpiRes {
    static constexpr bool PERM = true, AFTER_DRAIN = false;
    const void* base; bf16_t* XB; float* SS;
    __device__ __forceinline__ void operator()(const f32x4 (&acc)[2][2][4][2], const Unit& u, int wr, int wc, int fr, int fq) const {
        const int row0 = u.pm * BM + wr * 64 + fr, col0 = u.pn * BM + wc * 32 + 8 * fq;
#pragma unroll
        for (int ai = 0; ai < 2; ++ai)
#pragma unroll
            for (int m = 0; m < 4; ++m) { const int row = row0 + ai * HALF + m * 16; const size_t off = (size_t)row * 2048 + col0; float ss = 0.f;
#pragma unroll
                for (int bj = 0; bj < 2; ++bj) { f32x4 b0, b1;
                    if constexpr (BASE_F32) { b0 = *(const f32x4*)((const float*)base + off + bj * HALF); b1 = *(const f32x4*)((const float*)base + off + bj * HALF + 4); }
                    else { const u32x4 bw = *(const u32x4*)((const bf16_t*)base + off + bj * HALF);
                        b0 = (f32x4){__uint_as_float(bw.x << 16), __uint_as_float(bw.x & 0xffff0000u), __uint_as_float(bw.y << 16), __uint_as_float(bw.y & 0xffff0000u)};
                        b1 = (f32x4){__uint_as_float(bw.z << 16), __uint_as_float(bw.z & 0xffff0000u), __uint_as_float(bw.w << 16), __uint_as_float(bw.w & 0xffff0000u)}; }
                    const f32x4 x0 = b0 + acc[ai][bj][m][0], x1 = b1 + acc[ai][bj][m][1];
                    ss += (x0[0] * x0[0] + x0[1] * x0[1]) + (x0[2] * x0[2] + x0[3] * x0[3]) + (x1[0] * x1[0] + x1[1] * x1[1]) + (x1[2] * x1[2] + x1[3] * x1[3]);
                    u32x4 hw; hw.x = cvt_pk_bf16(x0[0], x0[1]); hw.y = cvt_pk_bf16(x0[2], x0[3]); hw.z = cvt_pk_bf16(x1[0], x1[1]); hw.w = cvt_pk_bf16(x1[2], x1[3]);
                    *(u32x4*)(XB + off + bj * HALF) = hw; }
                ss += __shfl_xor(ss, 16); ss += __shfl_xor(ss, 32); if (fq == 0) SS[(size_t)row * 32 + u.pn * 4 + wc] = ss;
                asm volatile("" ::: "memory"); }
    }
};
struct EpiFinal {
    static constexpr bool PERM = true, AFTER_DRAIN = false;
    const bf16_t* base; float* out; const float* wf; float* SS; unsigned* cnt; unsigned* tmo; PG8_LAS float* rl;
    __device__ __forceinline__ void operator()(const f32x4 (&acc_)[2][2][4][2], const Unit& u, int wr, int wc, int fr, int fq) const {
        f32x4 (&acc)[2][2][4][2] = const_cast<f32x4 (&)[2][2][4][2]>(acc_);
        const int row0 = u.pm * BM + wr * 64 + fr, col0 = u.pn * BM + wc * 32 + 8 * fq, rloc = wr * 64 + fr;
#pragma unroll
        for (int ai = 0; ai < 2; ++ai)
#pragma unroll
            for (int m = 0; m < 4; ++m) { const int row = row0 + ai * HALF + m * 16; const size_t off = (size_t)row * 2048 + col0; float ss = 0.f;
#pragma unroll
                for (int bj = 0; bj < 2; ++bj) { const u32x4 bw = *(const u32x4*)(base + off + bj * HALF);
                    const f32x4 b0 = (f32x4){__uint_as_float(bw.x << 16), __uint_as_float(bw.x & 0xffff0000u), __uint_as_float(bw.y << 16), __uint_as_float(bw.y & 0xffff0000u)};
                    const f32x4 b1 = (f32x4){__uint_as_float(bw.z << 16), __uint_as_float(bw.z & 0xffff0000u), __uint_as_float(bw.w << 16), __uint_as_float(bw.w & 0xffff0000u)};
                    const f32x4 x0 = b0 + acc[ai][bj][m][0], x1 = b1 + acc[ai][bj][m][1];
                    acc[ai][bj][m][0] = x0; acc[ai][bj][m][1] = x1;
                    ss += (x0[0] * x0[0] + x0[1] * x0[1]) + (x0[2] * x0[2] + x0[3] * x0[3]) + (x1[0] * x1[0] + x1[1] * x1[1]) + (x1[2] * x1[2] + x1[3] * x1[3]); }
                ss += __shfl_xor(ss, 16); ss += __shfl_xor(ss, 32); if (fq == 0) SS[(size_t)row * 32 + u.pn * 4 + wc] = ss;
                asm volatile("" ::: "memory"); }
        asm volatile("s_waitcnt vmcnt(0)" ::: "memory");
        __syncthreads();
        if (threadIdx.x == 0) {
            __builtin_amdgcn_fence(__ATOMIC_RELEASE, "agent"); asm volatile("s_waitcnt vmcnt(0)" ::: "memory");
            (void)__hip_atomic_fetch_add(&cnt[u.pm * 64], 1u, __ATOMIC_RELAXED, __HIP_MEMORY_SCOPE_AGENT);
            unsigned sp = 0;
            while (__hip_atomic_load(&cnt[u.pm * 64], __ATOMIC_RELAXED, __HIP_MEMORY_SCOPE_AGENT) < 8u) { __builtin_amdgcn_s_sleep(1);
                if ((++sp & 255u) == 0u) { if (__hip_atomic_load(tmo, __ATOMIC_RELAXED, __HIP_MEMORY_SCOPE_AGENT)) break; if (sp > (1u << 18)) { atomicAdd(tmo, 1u); break; } } }
            __builtin_amdgcn_fence(__ATOMIC_ACQUIRE, "agent"); asm volatile("s_waitcnt vmcnt(0)" ::: "memory");
        }
        __syncthreads();
        row_rstd(SS, u.pm, rl);
        f32x4 w[2][2];
#pragma unroll
        for (int bj = 0; bj < 2; ++bj) { w[bj][0] = *(const f32x4*)(wf + col0 + bj * HALF); w[bj][1] = *(const f32x4*)(wf + col0 + bj * HALF + 4); }
#pragma unroll
        for (int ai = 0; ai < 2; ++ai)
#pragma unroll
            for (int m = 0; m < 4; ++m) { const int row = row0 + ai * HALF + m * 16; const size_t off = (size_t)row * 2048 + col0; const float rs = rl[rloc + ai * HALF + m * 16];
#pragma unroll
                for (int bj = 0; bj < 2; ++bj) { *(f32x4*)(out + off + bj * HALF) = acc[ai][bj][m][0] * rs * w[bj][0]; *(f32x4*)(out + off + bj * HALF + 4) = acc[ai][bj][m][1] * rs * w[bj][1]; } }
    }
};
struct EpiSwiglu {
    static constexpr bool PERM = true, AFTER_DRAIN = false;
    bf16_t* O; const float* SS; PG8_LAS float* rl4; int grp;
    __device__ __forceinline__ void operator()(const f32x4 (&acc)[2][2][4][2], const Unit& u, int wr, int wc, int fr, int fq) const {
        PG8_LAS float* rl = tile_rstd(u.pm, rl4);
        const int row0 = u.pm * BM + wr * 64 + fr, col0 = u.pn * HALF + wc * 32 + 8 * fq, rloc = wr * 64 + fr;
#pragma unroll
        for (int ai = 0; ai < 2; ++ai)
#pragma unroll
            for (int m = 0; m < 4; ++m) { bf16_t* rowp = O + (size_t)(row0 + ai * HALF + m * 16) * 5632 + col0; const float rs = rl[rloc + ai * HALF + m * 16];
                float r[8];
#pragma unroll
                for (int n = 0; n < 2; ++n)
#pragma unroll
                    for (int j = 0; j < 4; ++j) { const float g = acc[ai][0][m][n][j] * rs, up = acc[ai][1][m][n][j] * rs;
                        r[n * 4 + j] = g * __builtin_amdgcn_rcpf(1.0f + __expf(-g)) * up; }
                u32x4 w; w.x = cvt_pk_bf16(r[0], r[1]); w.y = cvt_pk_bf16(r[2], r[3]); w.z = cvt_pk_bf16(r[4], r[5]); w.w = cvt_pk_bf16(r[6], r[7]);
                *(u32x4*)rowp = w; }
    }
};

template <class Epi, class Sched, bool ALIGN_EPI = false, bool SP2 = false>
__device__ __forceinline__ void gemm_phase(PG8_LAS unsigned char* lds, const Gemm g, const Sched& S, const Epi& E) {
    int tid_ = threadIdx.x; asm volatile("" : "+v"(tid_));
    const int tid = tid_, wid = __builtin_amdgcn_readfirstlane(tid >> 6), lane = tid & 63, wr = wid >> 2, wc = wid & 3, fr = lane & 15, fq = lane >> 4;
    const int K = g.K, nt = K / BK;
    unsigned voffA[2], voffB[2];
#pragma unroll
    for (int i = 0; i < 2; ++i) { int R, C; stage_rc(tid * 16 + i * 8192, R, C); const int Rb = Epi::PERM ? ((R & ~31) + perm32(R & 31)) : R;
        voffA[i] = (unsigned)(R * K + C) * 2u; voffB[i] = (unsigned)(Rb * K + C) * 2u; }
    const size_t kstep = (size_t)(BK * 2);
    const size_t hstep = (size_t)HALF * K * 2;
    const size_t tstep = 2 * hstep;
    const unsigned ldsw = (unsigned)wid * 1024u;
    const int aoff = lds_byte(wr * 64 + fr, fq * 8), boff = lds_byte(wc * 32 + fr, fq * 8);
#define PG8_SA(b, h) (((b) * 2 + (h)) * HTB)
#define PG8_SB(b, h) ((4 + (b) * 2 + (h)) * HTB)
#define PG8_STAGE(bufoff, gbase, voff) do { _Pragma("unroll") for (int _i = 0; _i < 2; ++_i) \
        __builtin_amdgcn_global_load_lds((const unsigned*)((const char*)(gbase) + (voff)[_i]), (PG8_LAS unsigned*)(lds + (bufoff) + ldsw + _i * 8192), 16, 0, 0); } while (0)
#define PG8_LDA(dst, b, h) do { _Pragma("unroll") for (int m = 0; m < 4; ++m) _Pragma("unroll") for (int k = 0; k < 2; ++k) dst[m][k] = *(const PG8_LAS bf16x8*)(lds + PG8_SA(b, h) + aoff + m * 2048 + k * 1024); } while (0)
#define PG8_LDB(dst, b, h) do { _Pragma("unroll") for (int n = 0; n < 2; ++n) _Pragma("unroll") for (int k = 0; k < 2; ++k) dst[n][k] = *(const PG8_LAS bf16x8*)(lds + PG8_SB(b, h) + boff + n * 2048 + k * 1024); } while (0)
#define PG8_MMA(ai, bj, At, Bt) do { __builtin_amdgcn_s_setprio(1); _Pragma("unroll") for (int m = 0; m < 4; ++m) _Pragma("unroll") for (int n = 0; n < 2; ++n) _Pragma("unroll") for (int k = 0; k < 2; ++k) \
        acc[ai][bj][m][n] = __builtin_amdgcn_mfma_f32_16x16x32_bf16(Bt[n][k], At[m][k], acc[ai][bj][m][n], 0, 0, 0); __builtin_amdgcn_s_setprio(0); } while (0)
#define PG8_WAIT_V(n) asm volatile("s_waitcnt vmcnt(" #n ")" ::: "memory")
#define PG8_WAIT_L(n) asm volatile("s_waitcnt lgkmcnt(" #n ")" ::: "memory")
#define PG8_BAR __builtin_amdgcn_s_barrier()
#define PG8_SCHED __builtin_amdgcn_sched_barrier(0)
    Unit cur, nxt; int ui = 0;
    if (!S.next(0, cur)) return;
    f32x4 acc[2][2][4][2];
#pragma unroll
    for (int a = 0; a < 2; ++a)
#pragma unroll
        for (int b = 0; b < 2; ++b)
#pragma unroll
            for (int m = 0; m < 4; ++m)
#pragma unroll
                for (int n = 0; n < 2; ++n) acc[a][b][m][n] = (f32x4){0.f, 0.f, 0.f, 0.f};
    bf16x8 At[4][2], B0[2][2], B1[2][2];
    const char* cA = (const char*)g.A + (size_t)cur.pm * tstep; const char* cB = (const char*)g.Bt + (size_t)cur.pn * tstep;
    S.a_ready(cur);
    if constexpr (SP2) {
        PG8_STAGE(PG8_SB(0, 0), cB, voffB); PG8_STAGE(PG8_SB(0, 1), cB + hstep, voffB); PG8_STAGE(PG8_SA(0, 0), cA, voffA); PG8_STAGE(PG8_SA(0, 1), cA + hstep, voffA);
        if (wr == 1) PG8_BAR;
        PG8_WAIT_V(2); PG8_BAR;
        PG8_STAGE(PG8_SB(1, 0), cB + kstep, voffB); PG8_STAGE(PG8_SA(1, 0), cA + kstep, voffA); PG8_STAGE(PG8_SB(1, 1), cB + hstep + kstep, voffB);
        PG8_WAIT_V(6); PG8_BAR;
    } else {
        PG8_STAGE(PG8_SB(0, 0), cB, voffB); PG8_STAGE(PG8_SA(0, 0), cA, voffA); PG8_STAGE(PG8_SB(0, 1), cB + hstep, voffB); PG8_STAGE(PG8_SA(0, 1), cA + hstep, voffA);
        if (wr == 1) PG8_BAR;
        PG8_WAIT_V(4); PG8_BAR;
        PG8_STAGE(PG8_SB(1, 0), cB + kstep, voffB); PG8_STAGE(PG8_SA(1, 0), cA + kstep, voffA); PG8_STAGE(PG8_SB(1, 1), cB + hstep + kstep, voffB);
        PG8_WAIT_V(6); PG8_BAR;
    }
    for (;;) {
        const bool has_next = S.next(ui + 1, nxt);
        const char* nA = has_next ? (const char*)g.A + (size_t)nxt.pm * tstep : cA; const char* nB = has_next ? (const char*)g.Bt + (size_t)nxt.pn * tstep : cB;
        for (int t = 0; t < nt; t += 2) {
            const bool last = (t == nt - 2);
            const char* a1 = cA + (size_t)(t + 1) * kstep;
            const char* a2 = last ? nA : cA + (size_t)(t + 2) * kstep; const char* b2 = last ? nB : cB + (size_t)(t + 2) * kstep;
            const char* a3 = a2 + kstep; const char* b3 = b2 + kstep;
            if (last && has_next) S.a_ready(nxt);
            if constexpr (SP2) {
            PG8_LDB(B0, 0, 0); PG8_LDB(B1, 0, 1); PG8_SCHED; PG8_LDA(At, 0, 0); PG8_STAGE(PG8_SA(1, 1), a1 + hstep, voffA);
            PG8_WAIT_V(8); PG8_WAIT_L(0); PG8_BAR; PG8_MMA(0, 0, At, B0); PG8_MMA(0, 1, At, B1); PG8_BAR; PG8_SCHED;
            PG8_LDA(At, 0, 1); PG8_STAGE(PG8_SB(0, 0), b2, voffB); PG8_STAGE(PG8_SB(0, 1), b2 + hstep, voffB); PG8_STAGE(PG8_SA(0, 0), a2, voffA);
            PG8_WAIT_V(8); PG8_WAIT_L(0); PG8_BAR; PG8_MMA(1, 0, At, B0); PG8_MMA(1, 1, At, B1); PG8_BAR; PG8_SCHED;
            PG8_LDB(B0, 1, 0); PG8_LDB(B1, 1, 1); PG8_SCHED; PG8_LDA(At, 1, 0); PG8_STAGE(PG8_SA(0, 1), a2 + hstep, voffA);
            PG8_WAIT_V(8); PG8_WAIT_L(0); PG8_BAR; PG8_MMA(0, 0, At, B0); PG8_MMA(0, 1, At, B1); PG8_BAR; PG8_SCHED;
            PG8_LDA(At, 1, 1); PG8_STAGE(PG8_SB(1, 0), b3, voffB); PG8_STAGE(PG8_SB(1, 1), b3 + hstep, voffB); PG8_STAGE(PG8_SA(1, 0), a3, voffA);
            PG8_WAIT_V(8); PG8_WAIT_L(0); PG8_BAR; PG8_MMA(1, 0, At, B0); PG8_MMA(1, 1, At, B1); PG8_BAR; PG8_SCHED;
            } else {
            PG8_LDB(B0, 0, 0); PG8_SCHED; PG8_LDA(At, 0, 0); PG8_STAGE(PG8_SA(1, 1), a1 + hstep, voffA);
            PG8_WAIT_L(8); PG8_BAR; PG8_WAIT_L(0); PG8_MMA(0, 0, At, B0); PG8_BAR; PG8_SCHED;
            PG8_LDB(B1, 0, 1); PG8_STAGE(PG8_SB(0, 0), b2, voffB);
            PG8_BAR; PG8_WAIT_L(0); PG8_MMA(0, 1, At, B1); PG8_BAR;
            PG8_LDA(At, 0, 1); PG8_STAGE(PG8_SA(0, 0), a2, voffA);
            PG8_BAR; PG8_WAIT_L(0); PG8_MMA(1, 0, At, B0); PG8_BAR; PG8_SCHED;
            PG8_STAGE(PG8_SB(0, 1), b2 + hstep, voffB);
            PG8_WAIT_V(6); PG8_BAR; PG8_MMA(1, 1, At, B1); PG8_BAR;
            PG8_LDB(B0, 1, 0); PG8_SCHED; PG8_LDA(At, 1, 0); PG8_STAGE(PG8_SA(0, 1), a2 + hstep, voffA);
            PG8_WAIT_L(8); PG8_BAR; PG8_WAIT_L(0); PG8_MMA(0, 0, At, B0); PG8_BAR; PG8_SCHED;
            PG8_LDB(B1, 1, 1); PG8_STAGE(PG8_SB(1, 0), b3, voffB);
            PG8_BAR; PG8_WAIT_L(0); PG8_MMA(0, 1, At, B1); PG8_BAR;
            PG8_LDA(At, 1, 1); PG8_STAGE(PG8_SA(1, 0), a3, voffA);
            PG8_BAR; PG8_WAIT_L(0); PG8_MMA(1, 0, At, B0); PG8_BAR; PG8_SCHED;
            PG8_STAGE(PG8_SB(1, 1), b3 + hstep, voffB);
            PG8_WAIT_V(6); PG8_BAR; PG8_MMA(1, 1, At, B1); PG8_BAR;
            }
        }
        if constexpr (ALIGN_EPI) { if (wr == 0) PG8_BAR; }
        if constexpr (!Epi::AFTER_DRAIN) { E(acc, cur, wr, wc, fr, fq); S.done(cur); }
        if (!has_next) break;
#pragma unroll
        for (int a = 0; a < 2; ++a)
#pragma unroll
            for (int b = 0; b < 2; ++b)
#pragma unroll
                for (int m = 0; m < 4; ++m)
#pragma unroll
                    for (int n = 0; n < 2; ++n) acc[a][b][m][n] = (f32x4){0.f, 0.f, 0.f, 0.f};
        cur = nxt; cA = nA; cB = nB; ++ui;
        if constexpr (ALIGN_EPI) { if (wr == 1) PG8_BAR; }
    }
    PG8_WAIT_V(0);
    if constexpr (!ALIGN_EPI) { if (wr == 0) PG8_BAR; }
    PG8_BAR;
    if constexpr (Epi::AFTER_DRAIN) { E.fused(acc, cur, wr, wc, fr, fq, lds, wid, lane); S.done(cur); }
#undef PG8_SA
#undef PG8_SB
#undef PG8_STAGE
#undef PG8_LDA
#undef PG8_LDB
#undef PG8_MMA
#undef PG8_WAIT_V
#undef PG8_WAIT_L
#undef PG8_BAR
#undef PG8_SCHED
}
}
namespace fox {
typedef unsigned short bf16;
typedef short bf16x8 __attribute__((ext_vector_type(8)));
typedef short s16x4 __attribute__((ext_vector_type(4)));
typedef float f32x16 __attribute__((ext_vector_type(16)));
typedef float f32x4 __attribute__((ext_vector_type(4)));
typedef unsigned u32x4 __attribute__((ext_vector_type(4)));
constexpr int D = 128, LDQ = 7168;
constexpr float SCALE = 0.08838834764831845f, THR = 8.f;
constexpr int NW = 8, QBLK = 32, KVBLK = 64, QB = NW * QBLK;
constexpr int SHM_V = KVBLK * D * 2, SHM_K = KVBLK * D * 2;
constexpr int OFF_WS = 2 * SHM_V + 2 * SHM_K, OFF_B = OFF_WS + NW * 64 * 4, OFF_Q = OFF_B + 2 * 256, LDS_BYTES = OFF_Q + NW * 8 * 1024;
#define KSWZ(row, colB) ((row) * 256 + ((colB) ^ (((row) & 7) << 4)))
#define SBAR() __builtin_amdgcn_sched_barrier(0)
__device__ __forceinline__ int v_st(int k, int c) { const int kk = (k & ~0xC) | ((k & 4) << 1) | ((k & 8) >> 1); return ((kk >> 3) * 4 + (c >> 5)) * 512 + ((kk & 7) * 32 + (c & 31)) * 2; }
__device__ __forceinline__ int v_rd_base(int lane) { return ((lane & 3) << 3) | (((lane >> 2) & 3) << 6) | (((lane >> 4) & 1) << 5) | (((lane >> 5) & 1) << 8); }
constexpr int v_rd_off(int d0, int ks, int half) { return d0 * 512 + ks * 4096 + half * 2048; }
__device__ __forceinline__ int crow(int r, int hi) { return (r & 3) + 8 * (r >> 2) + 4 * hi; }
__device__ __forceinline__ unsigned cvtpk(float lo, float hi) { unsigned r; asm volatile("v_cvt_pk_bf16_f32 %0, %1, %2" : "=v"(r) : "v"(lo), "v"(hi)); return r; }
__device__ __forceinline__ bf16x8 load8(const bf16* p) { return *reinterpret_cast<const bf16x8*>(p); }
__device__ __forceinline__ void mask_tile(f32x16& p0, f32x16& p1, int dq) {
    const float NEG = -__builtin_inff();
#pragma unroll
    for (int r = 0; r < 16; ++r) { const int c = (r & 3) + 8 * (r >> 2);
        if (dq - c < 0) p0[r] = NEG;
        if (dq - c - 32 < 0) p1[r] = NEG; }
}
__device__ __forceinline__ void partialSM(f32x16& p0, f32x16& p1, float& m_reg, float& mn, float& alpha) {
    float pmax = p0[0];
#pragma unroll
    for (int r = 1; r < 16; ++r) pmax = fmaxf(pmax, p0[r]);
#pragma unroll
    for (int r = 0; r < 16; ++r) pmax = fmaxf(pmax, p1[r]);
    { auto rr = __builtin_amdgcn_permlane32_swap(__float_as_uint(pmax), __float_as_uint(pmax), false, false);
      pmax = fmaxf(__uint_as_float(rr[0]), __uint_as_float(rr[1])); }
    constexpr float C2 = 1.4426950408889634f * SCALE;
    if (__builtin_expect(__all((pmax - m_reg) * SCALE <= THR), 1)) { mn = m_reg; alpha = 1.f; }
    else { mn = fmaxf(m_reg, pmax); alpha = __builtin_amdgcn_exp2f((m_reg - mn) * C2); m_reg = mn; }
    const float mnL = -mn * C2;
#pragma unroll
    for (int r = 0; r < 16; ++r) p0[r] = fmaf(p0[r], C2, mnL);
#pragma unroll
    for (int r = 0; r < 16; ++r) p1[r] = fmaf(p1[r], C2, mnL);
#pragma unroll
    for (int r = 0; r < 16; ++r) p0[r] = __builtin_amdgcn_exp2f(p0[r]);
}
__device__ __forceinline__ void finishSM(f32x16& p0, f32x16& p1, float alpha, float& l_reg, bf16x8& pa0, bf16x8& pa1, bf16x8& pa2, bf16x8& pa3) {
#pragma unroll
    for (int r = 0; r < 16; ++r) p1[r] = __builtin_amdgcn_exp2f(p1[r]);
    float ps = 0;
#pragma unroll
    for (int r = 0; r < 16; ++r) ps += p0[r];
#pragma unroll
    for (int r = 0; r < 16; ++r) ps += p1[r];
    { auto rr = __builtin_amdgcn_permlane32_swap(__float_as_uint(ps), __float_as_uint(ps), false, false);
      ps = __uint_as_float(rr[0]) + __uint_as_float(rr[1]); }
    l_reg = l_reg * alpha + ps;
#define PK4(P, B_, OUT) do { unsigned a0 = cvtpk(P[B_+0], P[B_+1]), a1 = cvtpk(P[B_+2], P[B_+3]);                          \
        unsigned b0 = cvtpk(P[B_+4], P[B_+5]), b1 = cvtpk(P[B_+6], P[B_+7]);                                             \
        auto r0 = __builtin_amdgcn_permlane32_swap(a0, b0, false, false); auto r1 = __builtin_amdgcn_permlane32_swap(a1, b1, false, false); \
        u32x4 w = {r0[0], r1[0], r0[1], r1[1]}; OUT = *reinterpret_cast<bf16x8*>(&w); } while (0)
    PK4(p0, 0, pa0); PK4(p0, 8, pa1); PK4(p1, 0, pa2); PK4(p1, 8, pa3);
#undef PK4
}
__device__ __forceinline__ void weightsM(f32x16& p0, f32x16& p1, const char* bbuf, float m2row, int hi, bool needmask, int dq) {
    const f32x4* bl = reinterpret_cast<const f32x4*>(bbuf) + hi; const float NEG = -__builtin_inff();
    asm volatile("" : "+v"(m2row) : "v"(p0[15]), "v"(p1[15]));
#pragma unroll
    for (int g = 0; g < 4; ++g) { const f32x4 a = bl[2 * g], b = bl[8 + 2 * g];
#pragma unroll
        for (int j = 0; j < 4; ++j) { const int c = j + 8 * g; float e0 = a[j] - m2row, e1 = b[j] - m2row;
            if (needmask) { if (dq - c < 0) e0 = NEG; if (dq - c - 32 < 0) e1 = NEG; }
            p0[4 * g + j] *= SCALE * __builtin_amdgcn_exp2f(e0); p1[4 * g + j] *= SCALE * __builtin_amdgcn_exp2f(e1); }
        SBAR(); }
}
__device__ __forceinline__ void finishM(f32x16& p0, f32x16& p1, float& l_reg, bf16x8& pa0, bf16x8& pa1, bf16x8& pa2, bf16x8& pa3) {
    float ps = 0;
#pragma unroll
    for (int r = 0; r < 16; ++r) ps += p0[r];
#pragma unroll
    for (int r = 0; r < 16; ++r) ps += p1[r];
    { auto rr = __builtin_amdgcn_permlane32_swap(__float_as_uint(ps), __float_as_uint(ps), false, false);
      ps = __uint_as_float(rr[0]) + __uint_as_float(rr[1]); }
    l_reg += ps;
#define PK4(P, B_, OUT) do { unsigned a0 = cvtpk(P[B_+0], P[B_+1]), a1 = cvtpk(P[B_+2], P[B_+3]);                          \
        unsigned b0 = cvtpk(P[B_+4], P[B_+5]), b1 = cvtpk(P[B_+6], P[B_+7]);                                             \
        auto r0 = __builtin_amdgcn_permlane32_swap(a0, b0, false, false); auto r1 = __builtin_amdgcn_permlane32_swap(a1, b1, false, false); \
        u32x4 w = {r0[0], r1[0], r0[1], r1[1]}; OUT = *reinterpret_cast<bf16x8*>(&w); } while (0)
    PK4(p0, 0, pa0); PK4(p0, 8, pa1); PK4(p1, 0, pa2); PK4(p1, 8, pa3);
#undef PK4
}
template <int KB, bool MM>
__device__ __forceinline__ void qkt(f32x16& p0, f32x16& p1, const char* K_lds, const char* B_lds, int r32, int hi, const bf16x8* qr, const char* qlds) {
    if constexpr (MM) { p0 = f32x16{}; p1 = f32x16{}; }
    else { const f32x4* bl = reinterpret_cast<const f32x4*>(B_lds + KB * 256) + hi;
#pragma unroll
      for (int g = 0; g < 4; ++g) { const f32x4 a = bl[2 * g], b = bl[8 + 2 * g];
          p0[4 * g + 0] = a[0]; p0[4 * g + 1] = a[1]; p0[4 * g + 2] = a[2]; p0[4 * g + 3] = a[3];
          p1[4 * g + 0] = b[0]; p1[4 * g + 1] = b[1]; p1[4 * g + 2] = b[2]; p1[4 * g + 3] = b[3]; } }
    const char* kb[4];
#pragma unroll
    for (int dd = 0; dd < 4; ++dd) kb[dd] = K_lds + KB * SHM_K + KSWZ(r32, (dd * 16 + hi * 8) * 2);
#pragma unroll
    for (int d0 = 0; d0 < 8; ++d0) { const char* a = kb[d0 & 3] + (d0 >> 2) * 128;
        bf16x8 b0 = *reinterpret_cast<const bf16x8*>(a);
        bf16x8 b1 = *reinterpret_cast<const bf16x8*>(a + 32 * 256);
        bf16x8 qf; if constexpr (MM) qf = *reinterpret_cast<const bf16x8*>(qlds + d0 * 1024); else qf = qr[d0];
        p0 = __builtin_amdgcn_mfma_f32_32x32x16_bf16(b0, qf, p0, 0, 0, 0);
        p1 = __builtin_amdgcn_mfma_f32_32x32x16_bf16(b1, qf, p1, 0, 0, 0); }
}
template <int VB>
__device__ __forceinline__ void pv_tile(f32x16* o, int vb0, bf16x8 pa0, bf16x8 pa1, bf16x8 pa2, bf16x8 pa3) {
#define TRRD(dst, off) asm volatile("ds_read_b64_tr_b16 %0, %1 offset:%2" : "=&v"(dst) : "v"(vb0), "i"(off) : "memory")
#define PV_D0(d0) do { s16x4 l0, l1, l2, l3, h0, h1, h2, h3; constexpr int b_ = VB * SHM_V + v_rd_off(d0, 0, 0); \
        TRRD(l0, b_); TRRD(h0, b_ + 2048); TRRD(l1, b_ + 4096); TRRD(h1, b_ + 6144); TRRD(l2, b_ + 8192); TRRD(h2, b_ + 10240); TRRD(l3, b_ + 12288); TRRD(h3, b_ + 14336); \
        asm volatile("s_waitcnt lgkmcnt(0)" ::: "memory"); SBAR(); \
        o[d0] = __builtin_amdgcn_mfma_f32_32x32x16_bf16(pa0, (bf16x8){l0[0], l0[1], l0[2], l0[3], h0[0], h0[1], h0[2], h0[3]}, o[d0], 0, 0, 0);   \
        o[d0] = __builtin_amdgcn_mfma_f32_32x32x16_bf16(pa1, (bf16x8){l1[0], l1[1], l1[2], l1[3], h1[0], h1[1], h1[2], h1[3]}, o[d0], 0, 0, 0);   \
        o[d0] = __builtin_amdgcn_mfma_f32_32x32x16_bf16(pa2, (bf16x8){l2[0], l2[1], l2[2], l2[3], h2[0], h2[1], h2[2], h2[3]}, o[d0], 0, 0, 0);   \
        o[d0] = __builtin_amdgcn_mfma_f32_32x32x16_bf16(pa3, (bf16x8){l3[0], l3[1], l3[2], l3[3], h3[0], h3[1], h3[2], h3[3]}, o[d0], 0, 0, 0); } while (0)
    PV_D0(0); PV_D0(1); PV_D0(2); PV_D0(3);
#undef PV_D0
#undef TRRD
}
struct BlockRef { const bf16* K; const float* CB; bf16* Y; const float* NW; int P0; int t0, nt; float* PO; float* ST; };
template <bool MM> struct Delta { static constexpr int DQ = MM ? -512 : -1024, DV = MM ? 512 : 1024, DG = 1024; };
struct Seam { bf16x8 qr[8]; bf16x8 st_v0, st_v1, st_k0, st_k1; };
#define ROW(p, k0, rr) ((p) + (size_t)((k0) + (rr)) * LDQ + sc)
#define VMW() asm volatile("s_waitcnt vmcnt(0)" ::: "memory")
#define VMWN(n) asm volatile("s_waitcnt vmcnt(%0)" :: "i"(n) : "memory")
#define SLOAD_H(Kp, Vp, k0) do { S.st_v0 = load8(ROW(Vp, k0, sr)); S.st_v1 = load8(ROW(Vp, k0, 32 + sr));              \
                         S.st_k0 = load8(ROW(Kp, k0, sr)); S.st_k1 = load8(ROW(Kp, k0, 32 + sr)); } while (0)
#define SWRITE_HK(bf) do { *(bf16x8*)(K_lds + (bf) * SHM_K + kws) = S.st_k0; *(bf16x8*)(K_lds + (bf) * SHM_K + kws + 32 * 256) = S.st_k1; } while (0)
#define BDMA(Bp, k0, bf) do { if (wid == 0) __builtin_amdgcn_global_load_lds((const unsigned*)((Bp) + (k0) + lane), (__attribute__((address_space(3))) unsigned*)(unsigned)(uintptr_t)(B_lds + (bf) * 256), 4, 0, 0); } while (0)
#define SWRITE_HV(bf) do { *(bf16x8*)(V_lds + (bf) * SHM_V + vst0) = S.st_v0; *(bf16x8*)(V_lds + (bf) * SHM_V + vst1) = S.st_v1; } while (0)
#define SWRITE_H(bf) do { SWRITE_HV(bf); SWRITE_HK(bf); } while (0)
template <bool MM>
__device__ __forceinline__ void prime(const BlockRef& cur, char* lds, Seam& S) {
    int tid_ = threadIdx.x; asm volatile("" : "+v"(tid_));
    const int tid = tid_, wid = __builtin_amdgcn_readfirstlane(tid >> 6), lane = tid & 63, r32 = lane & 31, hi = lane >> 5;
    const int sr = tid >> 4, sc = (tid & 15) * 8, kws = KSWZ(sr, sc * 2); char* K_lds = lds + 2 * SHM_V; char* B_lds = lds + OFF_B;
#pragma unroll
    for (int d0 = 0; d0 < 8; ++d0) { const bf16x8 qf = load8(cur.K + Delta<MM>::DQ + (size_t)(cur.P0 + wid * QBLK + r32) * LDQ + d0 * 16 + hi * 8);
        if constexpr (MM) *reinterpret_cast<bf16x8*>(lds + OFF_Q + (wid * 8 + d0) * 1024 + lane * 16) = qf; else S.qr[d0] = qf; }
    BDMA(cur.CB, cur.t0 * KVBLK, 0); SLOAD_H(cur.K, cur.K + Delta<MM>::DV, cur.t0 * KVBLK); VMW(); SWRITE_HK(0);
    __syncthreads();
}
template <bool MM>
__device__ __forceinline__ void block(const BlockRef& cur, char* lds, Seam& S) {
    int tid_ = threadIdx.x; asm volatile("" : "+v"(tid_));
    const int tid = tid_, wid = __builtin_amdgcn_readfirstlane(tid >> 6), lane = tid & 63, r32 = lane & 31, hi = lane >> 5;
    const int NT = cur.nt;
    const int qlo = cur.P0 + wid * QBLK, qm = qlo + r32 - 4 * hi;
    char* V_lds = lds; char* K_lds = lds + 2 * SHM_V; char* B_lds = lds + OFF_B;
    float* ws = (float*)(lds + OFF_WS) + wid * 64; float* li_l = ws, * al_l = ws + 32;
    float m_reg = -1e30f, l_reg = 0; f32x16 o[4] = {};
    float m2row = 0.f; if constexpr (MM) m2row = cur.CB[32768 + qlo + r32];
    const char* qlds = lds + OFF_Q + wid * 8192 + lane * 16;
    const int sr = tid >> 4, sc = (tid & 15) * 8, vst0 = v_st(sr, sc), vst1 = v_st(32 + sr, sc), kws = KSWZ(sr, sc * 2);
    const int vb0 = (int)(uintptr_t)V_lds + v_rd_base(lane);
    const bf16* Kh = cur.K; const bf16* Vh = cur.K + Delta<MM>::DV; const float* Bh = cur.CB;
#define RESC(a) do { if (__any((a) < 1.f)) { if (hi == 0) al_l[r32] = (a); asm volatile("s_waitcnt lgkmcnt(0)" ::: "memory");              \
                     for (int d_ = 0; d_ < 4; ++d_) for (int r = 0; r < 16; ++r) o[d_][r] *= al_l[crow(r, hi)]; } } while (0)
#define KBASE(t) ((cur.t0 + (t)) * KVBLK)
#define MASKT(P0_, P1_, t) do { const int kb_ = KBASE(t); if (kb_ + KVBLK - 1 > qlo) mask_tile(P0_, P1_, qm - kb_); } while (0)
#define SMA(P0_, P1_, mnX, alX, t, BF) do { if constexpr (MM) { const int kb_ = KBASE(t); weightsM(P0_, P1_, B_lds + (BF) * 256, m2row, hi, kb_ + KVBLK - 1 > qlo, qm - kb_); } \
                                           else { MASKT(P0_, P1_, t); partialSM(P0_, P1_, m_reg, mnX, alX); } } while (0)
#define SMB(P0_, P1_, alY) do { if constexpr (MM) finishM(P0_, P1_, l_reg, pa0, pa1, pa2, pa3); else finishSM(P0_, P1_, alY, l_reg, pa0, pa1, pa2, pa3); } while (0)
    f32x16 pA0, pA1, pB0, pB1; float mnA, mnB, alA, alB; bf16x8 pa0, pa1, pa2, pa3;
    SWRITE_HV(0); SBAR();
    if (NT > 1) { BDMA(Bh, KBASE(1), 1); SLOAD_H(Kh, Vh, KBASE(1)); }
    SBAR(); qkt<0, MM>(pA0, pA1, K_lds, B_lds, r32, hi, S.qr, qlds);
    SMA(pA0, pA1, mnA, alA, 0, 0);
    if (NT > 1) { VMW(); SWRITE_H(1); }
    __syncthreads();
#define HALF_STEP(PX0, PX1, mnX, alX, PY0, PY1, alY, t, KB, VB, SB) do {                                                      \
        SBAR(); qkt<KB, MM>(PX0, PX1, K_lds, B_lds, r32, hi, S.qr, qlds);                                                    \
        SMB(PY0, PY1, alY); SBAR();                                                                                           \
        if ((t) + 1 < NT) { BDMA(Bh, KBASE((t) + 1), SB); SLOAD_H(Kh, Vh, KBASE((t) + 1)); SBAR(); }                          \
        pv_tile<VB>(o, vb0, pa0, pa1, pa2, pa3); SMA(PX0, PX1, mnX, alX, (t), KB);                                            \
        __syncthreads();                                                                                                      \
        if ((t) + 1 < NT) { VMW(); SWRITE_H(SB); }                                                                            \
        if constexpr (!MM) RESC(alX);                                                                                         \
        __syncthreads(); } while (0)
    for (int t = 1; t + 1 < NT; t += 2) {
        HALF_STEP(pB0, pB1, mnB, alB, pA0, pA1, alA, t, 1, 0, 0);
        HALF_STEP(pA0, pA1, mnA, alA, pB0, pB1, alB, t + 1, 0, 1, 1);
    }
    const bool even = (NT & 1) == 0;
    if (even) { SBAR(); qkt<1, MM>(pB0, pB1, K_lds, B_lds, r32, hi, S.qr, qlds); SBAR(); }
    SMB(pA0, pA1, alA); SBAR();
    pv_tile<0>(o, vb0, pa0, pa1, pa2, pa3);
    if (even) { SMA(pB0, pB1, mnB, alB, NT - 1, 1); __syncthreads(); if constexpr (!MM) RESC(alB);
        SMB(pB0, pB1, alB); SBAR(); pv_tile<1>(o, vb0, pa0, pa1, pa2, pa3); }
    if constexpr (MM) l_reg = fmaxf(fabsf(l_reg), cur.CB[65536 + qlo + r32]);
    if (hi == 0) li_l[r32] = l_reg; asm volatile("s_waitcnt lgkmcnt(0)" ::: "memory");
    float rli[16];
#pragma unroll
    for (int r = 0; r < 16; ++r) rli[r] = __builtin_amdgcn_rcpf(li_l[crow(r, hi)]);
    if constexpr (MM) {
        float* Ow = (float*)cur.Y + (size_t)(cur.P0 + wid * QBLK) * 512;
#pragma unroll
        for (int r = 0; r < 16; ++r) { const int orow = crow(r, hi);
#pragma unroll
            for (int d0 = 0; d0 < 4; ++d0) Ow[(size_t)orow * 512 + d0 * 32 + r32] = o[d0][r] * rli[r]; }
    } else if (cur.PO != nullptr) {
        if (hi == 0) { float* st = cur.ST + (size_t)(qlo + r32 - 2048) * 16; st[0] = m_reg; st[1] = l_reg; }
        float* Ow = cur.PO + (size_t)(qlo - 2048) * 1024 + r32;
#pragma unroll
        for (int r = 0; r < 16; ++r) { const int orow = crow(r, hi);
#pragma unroll
            for (int d0 = 0; d0 < 4; ++d0) Ow[(size_t)orow * 1024 + d0 * 32] = o[d0][r] * rli[r]; }
    } else {
    float nw[4];
#pragma unroll
    for (int d0 = 0; d0 < 4; ++d0) nw[d0] = cur.NW[d0 * 32 + r32];
    bf16* Yw = cur.Y + (size_t)(cur.P0 + wid * QBLK) * 2048 + r32;
#pragma unroll
    for (int r = 0; r < 16; ++r) { const int orow = crow(r, hi);
        const float v0 = o[0][r] * rli[r], v1 = o[1][r] * rli[r], v2 = o[2][r] * rli[r], v3 = o[3][r] * rli[r];
        float s2 = (v0 * v0 + v1 * v1) + (v2 * v2 + v3 * v3), s1 = (v0 + v1) + (v2 + v3);
        s2 += __shfl_xor(s2, 1); s2 += __shfl_xor(s2, 2); s2 += __shfl_xor(s2, 4); s2 += __shfl_xor(s2, 8); s2 += __shfl_xor(s2, 16);
        float mean = 0.f;
        if constexpr (MM) { s1 += __shfl_xor(s1, 1); s1 += __shfl_xor(s1, 2); s1 += __shfl_xor(s1, 4); s1 += __shfl_xor(s1, 8); s1 += __shfl_xor(s1, 16); mean = s1 * (1.0f / 128.0f); }
        const float rstd = 1.0f / sqrtf(fmaxf(s2 * (1.0f / 128.0f) - mean * mean, 0.f) + 1e-6f);
        float y0 = (v0 - mean) * rstd * nw[0], y1 = (v1 - mean) * rstd * nw[1], y2 = (v2 - mean) * rstd * nw[2], y3 = (v3 - mean) * rstd * nw[3];
        if constexpr (MM) { const bf16* gp = cur.K + Delta<MM>::DG + (size_t)(cur.P0 + wid * QBLK + orow) * LDQ + r32;
            const float g0 = __uint_as_float((unsigned)gp[0] << 16), g1 = __uint_as_float((unsigned)gp[32] << 16), g2 = __uint_as_float((unsigned)gp[64] << 16), g3 = __uint_as_float((unsigned)gp[96] << 16);
            y0 *= __builtin_amdgcn_rcpf(1.0f + __expf(-g0)); y1 *= __builtin_amdgcn_rcpf(1.0f + __expf(-g1)); y2 *= __builtin_amdgcn_rcpf(1.0f + __expf(-g2)); y3 *= __builtin_amdgcn_rcpf(1.0f + __expf(-g3)); }
        bf16* yp = Yw + (size_t)orow * 2048;
        yp[0] = (bf16)(cvtpk(y0, 0.f) & 0xffffu); yp[32] = (bf16)(cvtpk(y1, 0.f) & 0xffffu); yp[64] = (bf16)(cvtpk(y2, 0.f) & 0xffffu); yp[96] = (bf16)(cvtpk(y3, 0.f) & 0xffffu); }
    }
    __syncthreads();
#undef RESC
#undef KBASE
#undef MASKT
#undef SMA
#undef SMB
#undef HALF_STEP
}
#undef ROW
#undef VMW
#undef VMWN
#undef SLOAD_H
#undef SWRITE_HK
#undef SWRITE_HV
#undef BDMA
#undef SWRITE_H
#undef KSWZ
#undef SBAR
}

namespace gdn {
typedef unsigned short bf16;
typedef short bf16x8 __attribute__((ext_vector_type(8)));
typedef short s16x4 __attribute__((ext_vector_type(4)));
typedef float f32x16 __attribute__((ext_vector_type(16)));
typedef float f32x4 __attribute__((ext_vector_type(4)));
typedef unsigned u32x4 __attribute__((ext_vector_type(4)));
typedef unsigned u32x2 __attribute__((ext_vector_type(2)));
constexpr int PK_WKN = 0, PK_QD = 16384, PK_AT = 32768, PK_KE = 38912, PK_BYTES = 55296, WV_BYTES = 16384;
constexpr int L_Q = 0, L_K = 16384, L_KV = 32768, L_VV = 49152, L_A = 65536, L_T2 = 82944, L_T1 = 92160, L_TD = 101376, L_XM = L_TD + 2 * 32 * 33 * 4, L_RAW = 65536  , L_WC = 117248  , L_SM = L_WC + 6144, PREP_LDS = L_SM + 5 * 256;
static_assert(L_RAW + 67 * 768 <= L_WC && L_XM + 32 * 33 * 4 <= L_WC, "gdn prep lds");
constexpr int A_LD = 68, T_LD = 72;
#define G_KSWZ(row, colB) ((row) * 256 + ((colB) ^ (((row) & 7) << 4)))
#define G_SBAR() __builtin_amdgcn_sched_barrier(0)
__device__ __forceinline__ int v_st(int k, int c) { const int kk = (k & ~0xC) | ((k & 4) << 1) | ((k & 8) >> 1); return ((kk >> 3) * 4 + (c >> 5)) * 512 + ((kk & 7) * 32 + (c & 31)) * 2; }
__device__ __forceinline__ int v_rd_base(int lane) { return ((lane & 3) << 3) | (((lane >> 2) & 3) << 6) | (((lane >> 4) & 1) << 5) | (((lane >> 5) & 1) << 8); }
__device__ __forceinline__ int crow(int r, int hi) { return (r & 3) + 8 * (r >> 2) + 4 * hi; }
typedef float f32x2_t __attribute__((ext_vector_type(2))); typedef __bf16 bf16x2_t __attribute__((ext_vector_type(2)));
__device__ __forceinline__ unsigned cvtpk(float lo, float hi) { f32x2_t v = {lo, hi}; bf16x2_t b = __builtin_convertvector(v, bf16x2_t); return __builtin_bit_cast(unsigned, b); }
__device__ __forceinline__ bf16x8 pack8(float a0, float a1, float a2, float a3, float a4, float a5, float a6, float a7) {
    u32x4 w = {cvtpk(a0, a1), cvtpk(a2, a3), cvtpk(a4, a5), cvtpk(a6, a7)}; return *reinterpret_cast<bf16x8*>(&w); }
__device__ __forceinline__ float blo(unsigned u) { return __uint_as_float(u << 16); }
__device__ __forceinline__ float bhi(unsigned u) { return __uint_as_float(u & 0xffff0000u); }
#define G_TR4(vb, d0, L0, H0, L1, H1, L2, H2, L3, H3) do { \
    asm volatile("ds_read_b64_tr_b16 %0, %1 offset:%2" : "=&v"(L0) : "v"(vb), "i"((d0) * 512) : "memory"); asm volatile("ds_read_b64_tr_b16 %0, %1 offset:%2" : "=&v"(H0) : "v"(vb), "i"((d0) * 512 + 2048) : "memory"); \
    asm volatile("ds_read_b64_tr_b16 %0, %1 offset:%2" : "=&v"(L1) : "v"(vb), "i"((d0) * 512 + 4096) : "memory"); asm volatile("ds_read_b64_tr_b16 %0, %1 offset:%2" : "=&v"(H1) : "v"(vb), "i"((d0) * 512 + 6144) : "memory"); \
    asm volatile("ds_read_b64_tr_b16 %0, %1 offset:%2" : "=&v"(L2) : "v"(vb), "i"((d0) * 512 + 8192) : "memory"); asm volatile("ds_read_b64_tr_b16 %0, %1 offset:%2" : "=&v"(H2) : "v"(vb), "i"((d0) * 512 + 10240) : "memory"); \
    asm volatile("ds_read_b64_tr_b16 %0, %1 offset:%2" : "=&v"(L3) : "v"(vb), "i"((d0) * 512 + 12288) : "memory"); asm volatile("ds_read_b64_tr_b16 %0, %1 offset:%2" : "=&v"(H3) : "v"(vb), "i"((d0) * 512 + 14336) : "memory"); \
    asm volatile("s_waitcnt lgkmcnt(0)" ::: "memory"); G_SBAR(); } while (0)
#define G_FR(L, H) ((bf16x8){L[0], L[1], L[2], L[3], H[0], H[1], H[2], H[3]})

__device__ __forceinline__ void prep_unit(int u, const bf16* P, const float* GR, const float* conv_w, const float* a_log, const float* dt_bias,
                                          unsigned char* GPK, float* GWV, float* GEG, char* lds) {
    int tid_ = threadIdx.x; asm volatile("" : "+v"(tid_));
    const int tid = tid_, lane = tid & 63, wid = __builtin_amdgcn_readfirstlane(tid >> 6), r32 = lane & 31, hi = lane >> 5;
    const int bh = u >> 6, n = u & 63, b = bh >> 2, h = bh & 3; const size_t row0 = (size_t)b * 4096 + (size_t)n * 64;
    float* sm_gc = (float*)(lds + L_SM); float* sm_beta = sm_gc + 64; float* sm_eg = sm_gc + 128; float* sm_kew = sm_gc + 192; float* sm_bg = sm_gc + 256;
    { char* RAW = lds + L_RAW; float* WC = (float*)(lds + L_WC);
      for (int c = tid; c < 67 * 48; c += 512) { const int r = c / 48, q = c % 48, g = q >> 4, cc = q & 15;
          u32x4 x = {0u, 0u, 0u, 0u};
          if (n * 64 - 3 + r >= 0) x = *(const u32x4*)(P + (row0 + r - 3) * 7168 + 5120 + g * 512 + h * 128 + cc * 8);
          *(u32x4*)(RAW + r * 768 + g * 256 + cc * 16) = x; }
      for (int c = tid; c < 4 * 3 * 32; c += 512) { const int j = c / 96, q = c % 96, g = q >> 5, cc = q & 31;
          *(f32x4*)(WC + (j * 3 + g) * 128 + cc * 4) = *(const f32x4*)(conv_w + j * 1536 + g * 512 + h * 128 + cc * 4); }
    }
    __syncthreads();
    { const int tok = tid >> 3, e8 = tid & 7; const char* RAW = lds + L_RAW; const float* WC = (const float*)(lds + L_WC);
#pragma unroll
      for (int g = 0; g < 3; ++g) {
        float acc[16];
#pragma unroll
        for (int i = 0; i < 16; ++i) acc[i] = 0.f;
#pragma unroll
        for (int j = 0; j < 4; ++j) {
            const char* src = RAW + (tok + j) * 768 + g * 256 + e8 * 32;
            const u32x4 x0 = *(const u32x4*)src, x1 = *(const u32x4*)(src + 16);
            const float* wp = WC + (j * 3 + g) * 128 + e8 * 16;
            const f32x4 w0 = *(const f32x4*)wp, w1 = *(const f32x4*)(wp + 4), w2 = *(const f32x4*)(wp + 8), w3 = *(const f32x4*)(wp + 12);
            acc[0] += w0[0] * blo(x0[0]); acc[1] += w0[1] * bhi(x0[0]); acc[2] += w0[2] * blo(x0[1]); acc[3] += w0[3] * bhi(x0[1]);
            acc[4] += w1[0] * blo(x0[2]); acc[5] += w1[1] * bhi(x0[2]); acc[6] += w1[2] * blo(x0[3]); acc[7] += w1[3] * bhi(x0[3]);
            acc[8] += w2[0] * blo(x1[0]); acc[9] += w2[1] * bhi(x1[0]); acc[10] += w2[2] * blo(x1[1]); acc[11] += w2[3] * bhi(x1[1]);
            acc[12] += w3[0] * blo(x1[2]); acc[13] += w3[1] * bhi(x1[2]); acc[14] += w3[2] * blo(x1[3]); acc[15] += w3[3] * bhi(x1[3]);
        }
        float ss = 0.f;
#pragma unroll
        for (int i = 0; i < 16; ++i) { const float v = acc[i]; acc[i] = v / (1.0f + __expf(-v)); ss += acc[i] * acc[i]; }
        if (g < 2) { ss += __shfl_xor(ss, 1); ss += __shfl_xor(ss, 2); ss += __shfl_xor(ss, 4);
            const float rn = (1.0f / sqrtf(ss + 1e-6f)) * (g == 0 ? 0.08838834764831845f : 1.0f);
#pragma unroll
            for (int i = 0; i < 16; ++i) acc[i] *= rn; }
        const bf16x8 o0 = pack8(acc[0], acc[1], acc[2], acc[3], acc[4], acc[5], acc[6], acc[7]), o1 = pack8(acc[8], acc[9], acc[10], acc[11], acc[12], acc[13], acc[14], acc[15]);
        const int c0 = e8 * 16;
        if (g == 0) { *(bf16x8*)(lds + L_Q + G_KSWZ(tok, c0 * 2)) = o0; *(bf16x8*)(lds + L_Q + G_KSWZ(tok, c0 * 2 + 16)) = o1; }
        else if (g == 1) { *(bf16x8*)(lds + L_K + G_KSWZ(tok, c0 * 2)) = o0; *(bf16x8*)(lds + L_K + G_KSWZ(tok, c0 * 2 + 16)) = o1;
                           *(bf16x8*)(lds + L_KV + v_st(tok, c0)) = o0; *(bf16x8*)(lds + L_KV + v_st(tok, c0 + 8)) = o1; }
        else { *(bf16x8*)(lds + L_VV + v_st(tok, c0)) = o0; *(bf16x8*)(lds + L_VV + v_st(tok, c0 + 8)) = o1; }
      }
      if (wid == 0) {
        const float rg = GR[(row0 + lane) * 32 + 16 + h], rb = GR[(row0 + lane) * 32 + 20 + h];
        const float xg = rg + dt_bias[h]; const float sp = fmaxf(xg, 0.f) + log1pf(expf(-fabsf(xg)));
        const float gt = -expf(a_log[h]) * sp, bt = 1.0f / (1.0f + expf(-rb));
        float gc = gt;
#pragma unroll
        for (int o = 1; o < 64; o <<= 1) { const float nb = __shfl_up(gc, o); if (lane >= o) gc += nb; }
        const float gl = __shfl(gc, 63);
        sm_gc[lane] = gc; sm_beta[lane] = bt; sm_eg[lane] = expf(gc); sm_kew[lane] = expf(gl - gc); sm_bg[lane] = bt * expf(gc);
        if (lane == 0) GEG[u] = expf(gl);
      }
    }
    __syncthreads();
    if (wid < 6) {
        const int prod = wid / 3, pr = wid % 3, tbp = (pr == 2) ? 1 : 0, tb = (pr == 0) ? 0 : 1;
        const char* Ab = lds + L_K + tbp * 32 * 256; const char* Bb = lds + (prod == 0 ? L_K : L_Q) + tb * 32 * 256;
        f32x16 acc = {};
#pragma unroll
        for (int d0 = 0; d0 < 8; ++d0) { const int off = G_KSWZ(r32, ((d0 & 3) * 16 + hi * 8) * 2) + (d0 >> 2) * 128;
            const bf16x8 a = *reinterpret_cast<const bf16x8*>(Ab + off), bb = *reinterpret_cast<const bf16x8*>(Bb + off);
            acc = __builtin_amdgcn_mfma_f32_32x32x16_bf16(a, bb, acc, 0, 0, 0); }
        const int t = 32 * tb + r32; const float gct = sm_gc[t], bt = sm_beta[t];
        float val[16];
#pragma unroll
        for (int g = 0; g < 4; ++g) { const int s0 = 32 * tbp + 8 * g + 4 * hi; const f32x4 gcs = *(const f32x4*)(sm_gc + s0);
#pragma unroll
            for (int j = 0; j < 4; ++j) { const int sp = s0 + j; const float e = acc[4 * g + j] * __expf(gct - gcs[j]);
                val[4 * g + j] = (prod == 0) ? ((sp < t) ? bt * e : 0.f) : ((sp <= t) ? e : 0.f); } }
        if (prod == 0) {
#pragma unroll
            for (int g = 0; g < 4; ++g) *(f32x4*)(lds + L_A + (t * A_LD + 32 * tbp + 8 * g + 4 * hi) * 4) = (f32x4){val[4 * g], val[4 * g + 1], val[4 * g + 2], val[4 * g + 3]};
        } else {
            const int pair = (pr == 0) ? 0 : (pr == 1 ? 1 : 2);
#pragma unroll
            for (int s = 0; s < 2; ++s) *(bf16x8*)(GPK + (size_t)u * PK_BYTES + PK_AT + (pair * 2 + s) * 1024 + lane * 16) =
                pack8(val[8 * s], val[8 * s + 1], val[8 * s + 2], val[8 * s + 3], val[8 * s + 4], val[8 * s + 5], val[8 * s + 6], val[8 * s + 7]);
        }
    }
    __syncthreads();
    float* TD = (float*)(lds + L_TD); float* XM = (float*)(lds + L_XM);
    if (wid < 2) {
        float tc[32]; const int jl = lane & 31;
        unsigned abase = (unsigned)(uintptr_t)(lds + L_A) + (unsigned)(wid * 32 * A_LD + wid * 32) * 4u; asm volatile("" : "+v"(abase));
#pragma unroll
        for (int i = 0; i < 32; ++i) { float a0 = (jl == i) ? 1.f : 0.f, a1 = 0.f, a2 = 0.f, a3 = 0.f;
#pragma unroll
            for (int l4 = 0; l4 < (i + 3) / 4; ++l4) { const f32x4 av = *(const __attribute__((address_space(3))) f32x4*)(abase + i * A_LD * 4 + l4 * 16);
                if (4 * l4 + 0 < i) a0 -= av[0] * tc[4 * l4 + 0]; if (4 * l4 + 1 < i) a1 -= av[1] * tc[4 * l4 + 1];
                if (4 * l4 + 2 < i) a2 -= av[2] * tc[4 * l4 + 2]; if (4 * l4 + 3 < i) a3 -= av[3] * tc[4 * l4 + 3]; }
            tc[i] = (a0 + a1) + (a2 + a3); }
        if (lane < 32) {
#pragma unroll
            for (int i = 0; i < 32; ++i) TD[(wid * 32 + i) * 33 + jl] = tc[i]; }
    } else {
        for (int f = wid - 2; f < 16; f += 6) { const int tb = f >> 3, i = (f >> 1) & 3, s = f & 1; const int t = 32 * tb + r32; const float eg = sm_eg[t];
            const int cb = (32 * i + 16 * s + 4 * hi) * 2;
            const u32x2 p0 = *(const u32x2*)(lds + L_Q + t * 256 + (((cb & ~15)) ^ ((t & 7) << 4)) + (cb & 8));
            const u32x2 p1 = *(const u32x2*)(lds + L_Q + t * 256 + ((((cb + 16) & ~15)) ^ ((t & 7) << 4)) + (cb & 8));
            *(bf16x8*)(GPK + (size_t)u * PK_BYTES + PK_QD + f * 1024 + lane * 16) =
                pack8(blo(p0[0]) * eg, bhi(p0[0]) * eg, blo(p0[1]) * eg, bhi(p0[1]) * eg, blo(p1[0]) * eg, bhi(p1[0]) * eg, blo(p1[1]) * eg, bhi(p1[1]) * eg); }
    }
    __syncthreads();
    { const int i = tid >> 4, j0 = (tid & 15) * 2;
      const float* ar = (const float*)(lds + L_A) + (32 + i) * A_LD; float x0 = 0.f, x1 = 0.f;
#pragma unroll 8
      for (int k = 0; k < 32; ++k) { const float av = ar[k]; x0 += av * TD[k * 33 + j0]; x1 += av * TD[k * 33 + j0 + 1]; }
      XM[i * 33 + j0] = x0; XM[i * 33 + j0 + 1] = x1; }
    __syncthreads();
    { const int i = tid >> 4, j0 = (tid & 15) * 2;
      float y0 = 0.f, y1 = 0.f;
#pragma unroll 8
      for (int k = 0; k < 32; ++k) { const float tv = TD[(32 + i) * 33 + k]; y0 -= tv * XM[k * 33 + j0]; y1 -= tv * XM[k * 33 + j0 + 1]; }
      unsigned* T2 = (unsigned*)(lds + L_T2); unsigned* T1 = (unsigned*)(lds + L_T1);
      const float be0 = sm_beta[j0], be1 = sm_beta[j0 + 1], bg0 = sm_bg[j0], bg1 = sm_bg[j0 + 1];
      const float ce0 = sm_beta[32 + j0], ce1 = sm_beta[33 + j0], cg0 = sm_bg[32 + j0], cg1 = sm_bg[33 + j0];
      const float t11a = TD[i * 33 + j0], t11b = TD[i * 33 + j0 + 1], t22a = TD[(32 + i) * 33 + j0], t22b = TD[(32 + i) * 33 + j0 + 1];
      T2[(i * T_LD + j0) >> 1] = cvtpk(t11a * be0, t11b * be1);                 T1[(i * T_LD + j0) >> 1] = cvtpk(t11a * bg0, t11b * bg1);
      T2[(i * T_LD + 32 + j0) >> 1] = 0u;                                        T1[(i * T_LD + 32 + j0) >> 1] = 0u;
      T2[((32 + i) * T_LD + j0) >> 1] = cvtpk(y0 * be0, y1 * be1);              T1[((32 + i) * T_LD + j0) >> 1] = cvtpk(y0 * bg0, y1 * bg1);
      T2[((32 + i) * T_LD + 32 + j0) >> 1] = cvtpk(t22a * ce0, t22b * ce1);     T1[((32 + i) * T_LD + 32 + j0) >> 1] = cvtpk(t22a * cg0, t22b * cg1); }
    __syncthreads();
    { const int tb = wid >> 2, dq = wid & 3;
      const int vbV = (int)(uintptr_t)(lds + L_VV) + v_rd_base(lane), vbK = (int)(uintptr_t)(lds + L_KV) + v_rd_base(lane);
      const char* t2p = lds + L_T2 + ((32 * tb + r32) * T_LD + 8 * hi) * 2; const char* t1p = lds + L_T1 + ((32 * tb + r32) * T_LD + 8 * hi) * 2;
      s16x4 l0, l1, l2, l3, h0, h1, h2, h3;
      { f32x16 acc = {};
        switch (dq) { case 0: G_TR4(vbV, 0, l0, h0, l1, h1, l2, h2, l3, h3); break; case 1: G_TR4(vbV, 1, l0, h0, l1, h1, l2, h2, l3, h3); break;
                      case 2: G_TR4(vbV, 2, l0, h0, l1, h1, l2, h2, l3, h3); break; default: G_TR4(vbV, 3, l0, h0, l1, h1, l2, h2, l3, h3); break; }
        acc = __builtin_amdgcn_mfma_f32_32x32x16_bf16(*reinterpret_cast<const bf16x8*>(t2p), G_FR(l0, h0), acc, 0, 0, 0);
        acc = __builtin_amdgcn_mfma_f32_32x32x16_bf16(*reinterpret_cast<const bf16x8*>(t2p + 32), G_FR(l1, h1), acc, 0, 0, 0);
        acc = __builtin_amdgcn_mfma_f32_32x32x16_bf16(*reinterpret_cast<const bf16x8*>(t2p + 64), G_FR(l2, h2), acc, 0, 0, 0);
        acc = __builtin_amdgcn_mfma_f32_32x32x16_bf16(*reinterpret_cast<const bf16x8*>(t2p + 96), G_FR(l3, h3), acc, 0, 0, 0);
        unsigned char* wv = (unsigned char*)GWV + (size_t)u * WV_BYTES + ((dq * 2 + tb) * 4) * 512 + lane * 8;
#pragma unroll
        for (int g = 0; g < 4; ++g) *(u32x2*)(wv + g * 512) = (u32x2){cvtpk(acc[4 * g], acc[4 * g + 1]), cvtpk(acc[4 * g + 2], acc[4 * g + 3])}; }
      switch (dq) { case 0: G_TR4(vbK, 0, l0, h0, l1, h1, l2, h2, l3, h3); break; case 1: G_TR4(vbK, 1, l0, h0, l1, h1, l2, h2, l3, h3); break;
                    case 2: G_TR4(vbK, 2, l0, h0, l1, h1, l2, h2, l3, h3); break; default: G_TR4(vbK, 3, l0, h0, l1, h1, l2, h2, l3, h3); break; }
      { f32x16 acc = {};
        acc = __builtin_amdgcn_mfma_f32_32x32x16_bf16(G_FR(l0, h0), *reinterpret_cast<const bf16x8*>(t1p), acc, 0, 0, 0);
        acc = __builtin_amdgcn_mfma_f32_32x32x16_bf16(G_FR(l1, h1), *reinterpret_cast<const bf16x8*>(t1p + 32), acc, 0, 0, 0);
        acc = __builtin_amdgcn_mfma_f32_32x32x16_bf16(G_FR(l2, h2), *reinterpret_cast<const bf16x8*>(t1p + 64), acc, 0, 0, 0);
        acc = __builtin_amdgcn_mfma_f32_32x32x16_bf16(G_FR(l3, h3), *reinterpret_cast<const bf16x8*>(t1p + 96), acc, 0, 0, 0);
#pragma unroll
        for (int s = 0; s < 2; ++s) *(bf16x8*)(GPK + (size_t)u * PK_BYTES + PK_WKN + (((tb * 4 + dq) * 2 + s)) * 1024 + lane * 16) =
            pack8(-acc[8 * s], -acc[8 * s + 1], -acc[8 * s + 2], -acc[8 * s + 3], -acc[8 * s + 4], -acc[8 * s + 5], -acc[8 * s + 6], -acc[8 * s + 7]); }
      { f32x16 acc = {}; const float kw = sm_kew[32 * tb + r32];
        bf16x8 dg0, dg1;
#pragma unroll
        for (int j = 0; j < 8; ++j) { const unsigned short wbits = (unsigned short)(cvtpk(kw, 0.f) & 0xffffu);
            dg0[j] = (short)((8 * hi + j == r32) ? wbits : 0); dg1[j] = (short)((16 + 8 * hi + j == r32) ? wbits : 0); }
        if (tb == 0) { acc = __builtin_amdgcn_mfma_f32_32x32x16_bf16(dg0, G_FR(l0, h0), acc, 0, 0, 0); acc = __builtin_amdgcn_mfma_f32_32x32x16_bf16(dg1, G_FR(l1, h1), acc, 0, 0, 0); }
        else { acc = __builtin_amdgcn_mfma_f32_32x32x16_bf16(dg0, G_FR(l2, h2), acc, 0, 0, 0); acc = __builtin_amdgcn_mfma_f32_32x32x16_bf16(dg1, G_FR(l3, h3), acc, 0, 0, 0); }
#pragma unroll
        for (int s = 0; s < 2; ++s) *(bf16x8*)(GPK + (size_t)u * PK_BYTES + PK_KE + (((dq * 2 + tb) * 2 + s)) * 1024 + lane * 16) =
            pack8(acc[8 * s], acc[8 * s + 1], acc[8 * s + 2], acc[8 * s + 3], acc[8 * s + 4], acc[8 * s + 5], acc[8 * s + 6], acc[8 * s + 7]); }
    }
    __syncthreads();
}


constexpr int MPK_QD = 0, MPK_AT = 16384, MPK_KE = 22528, MPK_BYTES = 38912, MWV_BYTES = 16384;
__device__ __forceinline__ void mlstm_prep_unit(int u, const bf16* P, const float* MB, const float* MM, unsigned char* GPK, unsigned char* GWV, float* GEG, char* lds) {
    int tid_ = threadIdx.x; asm volatile("" : "+v"(tid_));
    const int tid = tid_, lane = tid & 63, wid = __builtin_amdgcn_readfirstlane(tid >> 6), r32 = lane & 31, hi = lane >> 5;
    const int bh = u >> 6, n = u & 63, b = bh >> 2, h = bh & 3; const size_t row0 = (size_t)b * 4096 + (size_t)n * 64;
    float* sm_b2 = (float*)(lds + L_SM); float* sm_m2 = sm_b2 + 64; float* sm_qf = sm_b2 + 128; float* sm_kf = sm_b2 + 192;
    { const int tok = tid >> 3, e8 = tid & 7, c0 = e8 * 16; const bf16* src = P + (row0 + tok) * 7168 + h * 128 + c0;
      const bf16x8 q0 = *(const bf16x8*)(src), q1 = *(const bf16x8*)(src + 8), k0 = *(const bf16x8*)(src + 512), k1 = *(const bf16x8*)(src + 520), v0 = *(const bf16x8*)(src + 1024), v1 = *(const bf16x8*)(src + 1032);
      *(bf16x8*)(lds + L_Q + G_KSWZ(tok, c0 * 2)) = q0; *(bf16x8*)(lds + L_Q + G_KSWZ(tok, c0 * 2 + 16)) = q1;
      *(bf16x8*)(lds + L_K + G_KSWZ(tok, c0 * 2)) = k0; *(bf16x8*)(lds + L_K + G_KSWZ(tok, c0 * 2 + 16)) = k1;
      *(bf16x8*)(lds + L_KV + v_st(tok, c0)) = k0; *(bf16x8*)(lds + L_KV + v_st(tok, c0 + 8)) = k1;
      *(bf16x8*)(lds + L_VV + v_st(tok, c0)) = v0; *(bf16x8*)(lds + L_VV + v_st(tok, c0 + 8)) = v1;
      bf16x8 idr = {0, 0, 0, 0, 0, 0, 0, 0};
#pragma unroll
      for (int j = 0; j < 8; ++j) idr[j] = (short)((8 * e8 + j == tok) ? 0x3f80 : 0);
      *(bf16x8*)(lds + L_T2 + tok * (T_LD * 2) + e8 * 16) = idr;
      if (wid == 0) {
        const size_t o = (size_t)bh * 4096 + n * 64; const float b2 = MB[o + lane], m2 = MM[o + lane];
        const float rn = (n > 0) ? MM[o - 1] : MM[o], rn1 = __shfl(m2, 63);
        sm_b2[lane] = b2; sm_m2[lane] = m2; sm_qf[lane] = exp2f(rn - m2); sm_kf[lane] = 0.08838834764831845f * exp2f(b2 - rn1);
        if (lane == 0) GEG[u] = exp2f(rn - rn1);
      }
    }
    __syncthreads();
    if (wid < 3) {
        const int pr = wid, tbp = (pr == 2) ? 1 : 0, tb = (pr == 0) ? 0 : 1;
        const char* Ab = lds + L_K + tbp * 32 * 256; const char* Bb = lds + L_Q + tb * 32 * 256;
        f32x16 acc = {};
#pragma unroll
        for (int d0 = 0; d0 < 8; ++d0) { const int off = G_KSWZ(r32, ((d0 & 3) * 16 + hi * 8) * 2) + (d0 >> 2) * 128;
            const bf16x8 a = *reinterpret_cast<const bf16x8*>(Ab + off), bb = *reinterpret_cast<const bf16x8*>(Bb + off);
            acc = __builtin_amdgcn_mfma_f32_32x32x16_bf16(a, bb, acc, 0, 0, 0); }
        const int t = 32 * tb + r32; const float m2t = sm_m2[t];
        float val[16];
#pragma unroll
        for (int g = 0; g < 4; ++g) { const int s0 = 32 * tbp + 8 * g + 4 * hi; const f32x4 b2s = *(const f32x4*)(sm_b2 + s0);
#pragma unroll
            for (int j = 0; j < 4; ++j) { const int sp = s0 + j; const float e = acc[4 * g + j] * (0.08838834764831845f * __builtin_amdgcn_exp2f(fminf(b2s[j] - m2t, 0.f)));
                val[4 * g + j] = (sp <= t) ? e : 0.f; } }
        const int pair = (pr == 0) ? 0 : (pr == 1 ? 1 : 2);
#pragma unroll
        for (int s = 0; s < 2; ++s) *(bf16x8*)(GPK + (size_t)u * MPK_BYTES + MPK_AT + (pair * 2 + s) * 1024 + lane * 16) =
            pack8(val[8 * s], val[8 * s + 1], val[8 * s + 2], val[8 * s + 3], val[8 * s + 4], val[8 * s + 5], val[8 * s + 6], val[8 * s + 7]);
    } else {
        for (int f = wid - 3; f < 16; f += 5) { const int tb = f >> 3, i = (f >> 1) & 3, s = f & 1; const int t = 32 * tb + r32; const float eg = sm_qf[t];
            const int cb = (32 * i + 16 * s + 4 * hi) * 2;
            const u32x2 p0 = *(const u32x2*)(lds + L_Q + t * 256 + (((cb & ~15)) ^ ((t & 7) << 4)) + (cb & 8));
            const u32x2 p1 = *(const u32x2*)(lds + L_Q + t * 256 + ((((cb + 16) & ~15)) ^ ((t & 7) << 4)) + (cb & 8));
            *(bf16x8*)(GPK + (size_t)u * MPK_BYTES + MPK_QD + f * 1024 + lane * 16) =
                pack8(blo(p0[0]) * eg, bhi(p0[0]) * eg, blo(p0[1]) * eg, bhi(p0[1]) * eg, blo(p1[0]) * eg, bhi(p1[0]) * eg, blo(p1[1]) * eg, bhi(p1[1]) * eg); }
    }
    { const int tb = wid >> 2, dq = wid & 3;
      const int vbV = (int)(uintptr_t)(lds + L_VV) + v_rd_base(lane), vbK = (int)(uintptr_t)(lds + L_KV) + v_rd_base(lane);
      const char* t2p = lds + L_T2 + ((32 * tb + r32) * T_LD + 8 * hi) * 2;
      s16x4 l0, l1, l2, l3, h0, h1, h2, h3;
      { f32x16 acc = {};
        switch (dq) { case 0: G_TR4(vbV, 0, l0, h0, l1, h1, l2, h2, l3, h3); break; case 1: G_TR4(vbV, 1, l0, h0, l1, h1, l2, h2, l3, h3); break;
                      case 2: G_TR4(vbV, 2, l0, h0, l1, h1, l2, h2, l3, h3); break; default: G_TR4(vbV, 3, l0, h0, l1, h1, l2, h2, l3, h3); break; }
        acc = __builtin_amdgcn_mfma_f32_32x32x16_bf16(*reinterpret_cast<const bf16x8*>(t2p), G_FR(l0, h0), acc, 0, 0, 0);
        acc = __builtin_amdgcn_mfma_f32_32x32x16_bf16(*reinterpret_cast<const bf16x8*>(t2p + 32), G_FR(l1, h1), acc, 0, 0, 0);
        acc = __builtin_amdgcn_mfma_f32_32x32x16_bf16(*reinterpret_cast<const bf16x8*>(t2p + 64), G_FR(l2, h2), acc, 0, 0, 0);
        acc = __builtin_amdgcn_mfma_f32_32x32x16_bf16(*reinterpret_cast<const bf16x8*>(t2p + 96), G_FR(l3, h3), acc, 0, 0, 0);
        unsigned char* wv = GWV + (size_t)u * MWV_BYTES + ((dq * 2 + tb) * 4) * 512 + lane * 8;
#pragma unroll
        for (int g = 0; g < 4; ++g) *(u32x2*)(wv + g * 512) = (u32x2){cvtpk(acc[4 * g], acc[4 * g + 1]), cvtpk(acc[4 * g + 2], acc[4 * g + 3])}; }
      switch (dq) { case 0: G_TR4(vbK, 0, l0, h0, l1, h1, l2, h2, l3, h3); break; case 1: G_TR4(vbK, 1, l0, h0, l1, h1, l2, h2, l3, h3); break;
                    case 2: G_TR4(vbK, 2, l0, h0, l1, h1, l2, h2, l3, h3); break; default: G_TR4(vbK, 3, l0, h0, l1, h1, l2, h2, l3, h3); break; }
      { f32x16 acc = {}; const float kw = sm_kf[32 * tb + r32];
        bf16x8 dg0, dg1;
#pragma unroll
        for (int j = 0; j < 8; ++j) { const unsigned short wbits = (unsigned short)(cvtpk(kw, 0.f) & 0xffffu);
            dg0[j] = (short)((8 * hi + j == r32) ? wbits : 0); dg1[j] = (short)((16 + 8 * hi + j == r32) ? wbits : 0); }
        if (tb == 0) { acc = __builtin_amdgcn_mfma_f32_32x32x16_bf16(dg0, G_FR(l0, h0), acc, 0, 0, 0); acc = __builtin_amdgcn_mfma_f32_32x32x16_bf16(dg1, G_FR(l1, h1), acc, 0, 0, 0); }
        else { acc = __builtin_amdgcn_mfma_f32_32x32x16_bf16(dg0, G_FR(l2, h2), acc, 0, 0, 0); acc = __builtin_amdgcn_mfma_f32_32x32x16_bf16(dg1, G_FR(l3, h3), acc, 0, 0, 0); }
#pragma unroll
        for (int s = 0; s < 2; ++s) *(bf16x8*)(GPK + (size_t)u * MPK_BYTES + MPK_KE + (((dq * 2 + tb) * 2 + s)) * 1024 + lane * 16) =
            pack8(acc[8 * s], acc[8 * s + 1], acc[8 * s + 2], acc[8 * s + 3], acc[8 * s + 4], acc[8 * s + 5], acc[8 * s + 6], acc[8 * s + 7]); }
    }
    __syncthreads();
}
constexpr int SC_RA = 40960, SC_RB = 22528, SC_A0 = 0, SC_B0 = 2 * SC_RA, SC_OUT = SC_B0 + 2 * SC_RB, SC_OROW = 144, SC_EG = SC_OUT + 64 * SC_OROW, SC_LDS = SC_EG + 256;
typedef unsigned u32x4s __attribute__((ext_vector_type(4)));
__device__ __forceinline__ void scan_unit(int bh, int half, const unsigned char* GPK, const float* GWV, const float* GEG, float* HG, char* lds) {
    int tid_ = threadIdx.x; asm volatile("" : "+v"(tid_));
    const int tid = tid_, lane = tid & 63, wid = __builtin_amdgcn_readfirstlane(tid >> 6), r32 = lane & 31, hi = lane >> 5;
    const int b = bh >> 2, h = bh & 3;
    const unsigned lds0 = (unsigned)(uintptr_t)lds;
    if (tid < 64) ((float*)(lds + SC_EG))[tid] = GEG[bh * 64 + tid];
    __syncthreads();
#define S_BAR() do { asm volatile("" ::: "memory"); __builtin_amdgcn_s_barrier(); asm volatile("" ::: "memory"); } while (0)
    if (wid >= 2 && wid < 7) {
        const int lw = wid - 2;
        const unsigned char* srcW = (const unsigned char*)GWV + (size_t)(bh * 64) * WV_BYTES + half * 8192 + lane * 16;
        const unsigned char* srcP = GPK + (size_t)(bh * 64) * PK_BYTES + lane * 16;
#define S_GLDS(src_, dst_) __builtin_amdgcn_global_load_lds((const unsigned*)(src_), (__attribute__((address_space(3))) unsigned*)(dst_), 16, 0, 0)
#define S_DMA_A(n_) do { const unsigned d_ = lds0 + SC_A0 + ((n_) & 1) * SC_RA; const unsigned char* w_ = srcW + (size_t)(n_) * WV_BYTES; const unsigned char* p_ = srcP + (size_t)(n_) * PK_BYTES; \
            _Pragma("unroll") for (int i_ = 0; i_ < 8; ++i_) { const int q_ = lw + 5 * i_; const unsigned char* s_ = (q_ < 8) ? w_ + q_ * 1024 : p_ + (q_ - 8) * 1024; S_GLDS(s_, d_ + q_ * 1024); } } while (0)
#define S_DMA_B(n_) do { const unsigned d_ = lds0 + SC_B0 + ((n_) & 1) * SC_RB; const unsigned char* p_ = srcP + (size_t)(n_) * PK_BYTES + PK_AT; \
            _Pragma("unroll") for (int i_ = 0; i_ < 5; ++i_) { const int q_ = lw + 5 * i_; if (q_ < 22) S_GLDS(p_ + q_ * 1024, d_ + q_ * 1024); } } while (0)
#define S_WAIT2() do { if (lw < 2) asm volatile("s_waitcnt vmcnt(13)" ::: "memory"); else asm volatile("s_waitcnt vmcnt(12)" ::: "memory"); } while (0)
        S_DMA_A(0); S_DMA_B(0); S_DMA_A(1); S_WAIT2();
        for (int n = 0; n < 64; ++n) {
            S_BAR();
            if (n + 1 < 64) { S_DMA_B(n + 1); S_WAIT2(); } else { asm volatile("s_waitcnt vmcnt(0)" ::: "memory"); }
            S_BAR();
            if (n + 2 < 64) { S_DMA_A(n + 2); S_WAIT2(); } else { asm volatile("s_waitcnt vmcnt(0)" ::: "memory"); }
        }
        S_BAR();
#undef S_GLDS
#undef S_DMA_A
#undef S_DMA_B
#undef S_WAIT2
    } else if (wid == 7) {
        char* og = (char*)((bf16*)HG + ((size_t)b * 4096) * 512 + h * 128 + half * 64);
        const char* ob = lds + SC_OUT;
#define S_STORE(t_) do { _Pragma("unroll") for (int i_ = 0; i_ < 8; ++i_) { const int idx_ = lane + 64 * i_, tok_ = idx_ >> 3, seg_ = idx_ & 7; \
            const u32x4s v_ = *(const u32x4s*)(ob + tok_ * SC_OROW + seg_ * 16); *(u32x4s*)(og + (size_t)((t_) * 64 + tok_) * 1024 + seg_ * 16) = v_; } } while (0)
        for (int n = 0; n < 64; ++n) { S_BAR(); if (n > 0) { S_STORE(n - 1); asm volatile("s_waitcnt lgkmcnt(0)" ::: "memory"); } S_BAR(); }
        S_BAR(); S_STORE(63);
#undef S_STORE
    } else {
        f32x16 S0 = {}, S1 = {}, S2 = {}, S3 = {};
        const float* egt = (const float*)(lds + SC_EG);
        char* ow = lds + SC_OUT + (wid * 32 + r32) * 2;
#define G_PK(X, s_) pack8(X[8 * (s_)], X[8 * (s_) + 1], X[8 * (s_) + 2], X[8 * (s_) + 3], X[8 * (s_) + 4], X[8 * (s_) + 5], X[8 * (s_) + 6], X[8 * (s_) + 7])
#define G_A(p_) (*reinterpret_cast<const bf16x8*>(p_))
#define G_MF(A_, B_, C_) C_ = __builtin_amdgcn_mfma_f32_32x32x16_bf16(A_, B_, C_, 0, 0, 0)
#define SA_LOAD(set_, k_) do { F[set_][0] = G_A(bA + 8192 + (k_) * 1024); F[set_][1] = G_A(bA + 16384 + (k_) * 1024); F[set_][2] = G_A(bA + 24576 + (k_) * 1024); F[set_][3] = G_A(bA + 32768 + (k_) * 1024); } while (0)
#define SK_LOAD(set_, j_) do { F[set_][0] = G_A(bB + 6144 + (0 * 4 + (j_)) * 1024); F[set_][1] = G_A(bB + 6144 + (1 * 4 + (j_)) * 1024); F[set_][2] = G_A(bB + 6144 + (2 * 4 + (j_)) * 1024); F[set_][3] = G_A(bB + 6144 + (3 * 4 + (j_)) * 1024); } while (0)
#define S_DECAY(X, s_) do { _Pragma("unroll") for (int j_ = 0; j_ < 8; ++j_) X[8 * (s_) + j_] *= eg; } while (0)
#define STEP_A(k_, SPC, SPN, NX, ns_) do { G_SBAR(); if ((k_) + 2 < 8) SA_LOAD(((k_) + 2) % 3, (k_) + 2); G_SBAR(); \
            G_MF(F[(k_) % 3][0], SPC, U0); G_MF(F[(k_) % 3][1], SPC, U1); G_MF(F[(k_) % 3][2], SPC, O0); G_MF(F[(k_) % 3][3], SPC, O1); \
            if ((k_) + 1 < 8) { SPN = G_PK(NX, ns_); S_DECAY(NX, ns_); } } while (0)
#define S_OUT(OX, tb_, r0_) do { _Pragma("unroll") for (int r_ = (r0_); r_ < (r0_) + 8; r_ += 2) { const unsigned pk_ = cvtpk(OX[r_], OX[r_ + 1]); \
            *(unsigned short*)(ow + (32 * (tb_) + crow(r_, hi)) * SC_OROW) = (unsigned short)(pk_ & 0xffffu); *(unsigned short*)(ow + (32 * (tb_) + crow(r_ + 1, hi)) * SC_OROW) = (unsigned short)(pk_ >> 16); } } while (0)
        for (int n = 0; n < 64; ++n) {
            asm volatile("s_waitcnt lgkmcnt(0)" ::: "memory"); S_BAR();
            const char* bA = lds + SC_A0 + (n & 1) * SC_RA + lane * 16;
            const char* bB = lds + SC_B0 + (n & 1) * SC_RB + lane * 16;
            const char* wv = lds + SC_A0 + (n & 1) * SC_RA + wid * 4096 + lane * 8;
            const float eg = egt[n];
            bf16x8 F[3][6];
            u32x2 w[8];
#pragma unroll
            for (int g = 0; g < 4; ++g) { w[g] = *(const u32x2*)(wv + g * 512); w[4 + g] = *(const u32x2*)(wv + 2048 + g * 512); }
            SA_LOAD(0, 0); SA_LOAD(1, 1);
            bf16x8 spa = G_PK(S0, 0), spb; S_DECAY(S0, 0);
            f32x16 U0, U1, O0 = {}, O1 = {};
#pragma unroll
            for (int g = 0; g < 4; ++g) { U0[4 * g] = blo(w[g][0]); U0[4 * g + 1] = bhi(w[g][0]); U0[4 * g + 2] = blo(w[g][1]); U0[4 * g + 3] = bhi(w[g][1]);
                U1[4 * g] = blo(w[4 + g][0]); U1[4 * g + 1] = bhi(w[4 + g][0]); U1[4 * g + 2] = blo(w[4 + g][1]); U1[4 * g + 3] = bhi(w[4 + g][1]); }
            STEP_A(0, spa, spb, S0, 1); STEP_A(1, spb, spa, S1, 0); STEP_A(2, spa, spb, S1, 1); STEP_A(3, spb, spa, S2, 0);
            STEP_A(4, spa, spb, S2, 1); STEP_A(5, spb, spa, S3, 0); STEP_A(6, spa, spb, S3, 1); STEP_A(7, spb, spa, S3, 1);
            S_BAR();
            G_SBAR();
#pragma unroll
            for (int q = 0; q < 6; ++q) F[0][q] = G_A(bB + q * 1024);
            SK_LOAD(1, 0);
            G_SBAR();
            const bf16x8 up0 = G_PK(U0, 0), up1 = G_PK(U0, 1), up2 = G_PK(U1, 0), up3 = G_PK(U1, 1);
            G_SBAR(); SK_LOAD(2, 1); G_SBAR();
            G_MF(F[0][0], up0, O0); G_MF(F[0][2], up0, O1); G_MF(F[0][1], up1, O0); G_MF(F[0][3], up1, O1); G_MF(F[0][4], up2, O1); G_MF(F[0][5], up3, O1);
            G_SBAR(); SK_LOAD(0, 2); G_SBAR();
            G_MF(F[1][0], up0, S0); G_MF(F[1][1], up0, S1); G_MF(F[1][2], up0, S2); G_MF(F[1][3], up0, S3);
            S_OUT(O0, 0, 0); S_OUT(O0, 0, 8);
            G_SBAR(); SK_LOAD(1, 3); G_SBAR();
            G_MF(F[2][0], up1, S0); G_MF(F[2][1], up1, S1); G_MF(F[2][2], up1, S2); G_MF(F[2][3], up1, S3);
            S_OUT(O1, 1, 0); S_OUT(O1, 1, 8);
            G_SBAR();
            G_MF(F[0][0], up2, S0); G_MF(F[0][1], up2, S1); G_MF(F[0][2], up2, S2); G_MF(F[0][3], up2, S3);
            G_MF(F[1][0], up3, S0); G_MF(F[1][1], up3, S1); G_MF(F[1][2], up3, S2); G_MF(F[1][3], up3, S3);
        }
        asm volatile("s_waitcnt lgkmcnt(0)" ::: "memory"); S_BAR();
#undef G_PK
#undef G_A
#undef G_MF
#undef SA_LOAD
#undef SK_LOAD
#undef S_DECAY
#undef STEP_A
#undef S_OUT
    }
#undef S_BAR
    __syncthreads();
}

constexpr int MS_RA = 24576, MS_RB = 22528, MS_A0 = 0, MS_B0 = 2 * MS_RA, MS_OUT = MS_B0 + 2 * MS_RB, MS_EG = MS_OUT + 64 * SC_OROW, MS_LDS = MS_EG + 256;
__device__ __forceinline__ void mscan2_unit(int bh, int half, const unsigned char* GPK, const unsigned char* GWV, const float* GEG, float* HM, float* DEN, char* lds) {
    int tid_ = threadIdx.x; asm volatile("" : "+v"(tid_));
    const int tid = tid_, lane = tid & 63, wid = __builtin_amdgcn_readfirstlane(tid >> 6), r32 = lane & 31, hi = lane >> 5;
    const int b = bh >> 2, h = bh & 3;
    const unsigned lds0 = (unsigned)(uintptr_t)lds;
    if (tid < 64) ((float*)(lds + MS_EG))[tid] = GEG[bh * 64 + tid];
    __syncthreads();
#define S_BAR() do { asm volatile("" ::: "memory"); __builtin_amdgcn_s_barrier(); asm volatile("" ::: "memory"); } while (0)
    if (wid >= 3 && wid < 7) {
        const int lw = wid - 3;
        const unsigned char* srcW = GWV + (size_t)(bh * 64) * MWV_BYTES + half * 8192 + lane * 16;
        const unsigned char* srcP = GPK + (size_t)(bh * 64) * MPK_BYTES + lane * 16;
#define S_GLDS(src_, dst_) __builtin_amdgcn_global_load_lds((const unsigned*)(src_), (__attribute__((address_space(3))) unsigned*)(dst_), 16, 0, 0)
#define S_DMA_A(n_) do { const unsigned d_ = lds0 + MS_A0 + ((n_) & 1) * MS_RA; const unsigned char* w_ = srcW + (size_t)(n_) * MWV_BYTES; const unsigned char* p_ = srcP + (size_t)(n_) * MPK_BYTES + MPK_QD; \
            _Pragma("unroll") for (int i_ = 0; i_ < 6; ++i_) { const int q_ = lw + 4 * i_; const unsigned char* s_ = (q_ < 8) ? w_ + q_ * 1024 : p_ + (q_ - 8) * 1024; S_GLDS(s_, d_ + q_ * 1024); } } while (0)
#define S_DMA_B(n_) do { const unsigned d_ = lds0 + MS_B0 + ((n_) & 1) * MS_RB; const unsigned char* p_ = srcP + (size_t)(n_) * MPK_BYTES + MPK_AT; \
            _Pragma("unroll") for (int i_ = 0; i_ < 6; ++i_) { const int q_ = lw + 4 * i_; if (q_ < 22) S_GLDS(p_ + q_ * 1024, d_ + q_ * 1024); } } while (0)
#define S_WAIT2() do { if (lw < 2) asm volatile("s_waitcnt vmcnt(12)" ::: "memory"); else asm volatile("s_waitcnt vmcnt(11)" ::: "memory"); } while (0)
        S_DMA_A(0); S_DMA_B(0); S_DMA_A(1); S_WAIT2();
        for (int n = 0; n < 64; ++n) {
            S_BAR();
            if (n + 1 < 64) { S_DMA_B(n + 1); S_WAIT2(); } else { asm volatile("s_waitcnt vmcnt(0)" ::: "memory"); }
            S_BAR();
            if (n + 2 < 64) { S_DMA_A(n + 2); S_WAIT2(); } else { asm volatile("s_waitcnt vmcnt(0)" ::: "memory"); }
        }
        S_BAR();
#undef S_GLDS
#undef S_DMA_A
#undef S_DMA_B
#undef S_WAIT2
    } else if (wid == 7) {
        char* og = (char*)((bf16*)HM + ((size_t)b * 4096) * 512 + h * 128 + half * 64);
        const char* ob = lds + MS_OUT;
#define S_STORE(t_) do { _Pragma("unroll") for (int i_ = 0; i_ < 8; ++i_) { const int idx_ = lane + 64 * i_, tok_ = idx_ >> 3, seg_ = idx_ & 7; \
            const u32x4s v_ = *(const u32x4s*)(ob + tok_ * SC_OROW + seg_ * 16); *(u32x4s*)(og + (size_t)((t_) * 64 + tok_) * 1024 + seg_ * 16) = v_; } } while (0)
        for (int n = 0; n < 64; ++n) { S_BAR(); if (n > 0) { S_STORE(n - 1); asm volatile("s_waitcnt lgkmcnt(0)" ::: "memory"); } S_BAR(); }
        S_BAR(); S_STORE(63);
#undef S_STORE
    } else if (wid == 2 && half != 0) {
        for (int n = 0; n < 64; ++n) { S_BAR(); S_BAR(); }
        S_BAR();
    } else {
        const bool den = (wid == 2);
        f32x16 S0 = {}, S1 = {}, S2 = {}, S3 = {};
        const float* egt = (const float*)(lds + MS_EG);
        char* ow = lds + MS_OUT + (wid * 32 + r32) * 2;
        const float one0 = (r32 == 0) ? 1.f : 0.f;
        const bf16x8 ones = pack8(one0, one0, one0, one0, one0, one0, one0, one0);
#define G_PK(X, s_) pack8(X[8 * (s_)], X[8 * (s_) + 1], X[8 * (s_) + 2], X[8 * (s_) + 3], X[8 * (s_) + 4], X[8 * (s_) + 5], X[8 * (s_) + 6], X[8 * (s_) + 7])
#define G_A(p_) (*reinterpret_cast<const bf16x8*>(p_))
#define G_MF(A_, B_, C_) C_ = __builtin_amdgcn_mfma_f32_32x32x16_bf16(A_, B_, C_, 0, 0, 0)
#define SA_LOAD(set_, j_) do { F[set_][0] = G_A(bA + 8192 + (2 * (j_)) * 1024); F[set_][1] = G_A(bA + 16384 + (2 * (j_)) * 1024); F[set_][2] = G_A(bA + 8192 + (2 * (j_) + 1) * 1024); F[set_][3] = G_A(bA + 16384 + (2 * (j_) + 1) * 1024); } while (0)
#define SK_LOAD(set_, j_) do { F[set_][0] = G_A(bB + 6144 + (0 * 4 + (j_)) * 1024); F[set_][1] = G_A(bB + 6144 + (1 * 4 + (j_)) * 1024); F[set_][2] = G_A(bB + 6144 + (2 * 4 + (j_)) * 1024); F[set_][3] = G_A(bB + 6144 + (3 * 4 + (j_)) * 1024); } while (0)
#define S_DECAY2(X) do { X *= eg; } while (0)
#define STEP_A(j_, NX) do { G_SBAR(); if ((j_) + 2 < 4) SA_LOAD(((j_) + 2) % 3, (j_) + 2); G_SBAR(); \
            G_MF(F[(j_) % 3][0], spa, O0); G_MF(F[(j_) % 3][1], spa, O1); G_MF(F[(j_) % 3][2], spb, O0); G_MF(F[(j_) % 3][3], spb, O1); \
            if ((j_) + 1 < 4) { spa = G_PK(NX, 0); spb = G_PK(NX, 1); S_DECAY2(NX); } } while (0)
#define S_OUT(OX, tb_, r0_) do { _Pragma("unroll") for (int r_ = (r0_); r_ < (r0_) + 8; r_ += 2) { const unsigned pk_ = cvtpk(OX[r_], OX[r_ + 1]); \
            *(unsigned short*)(ow + (32 * (tb_) + crow(r_, hi)) * SC_OROW) = (unsigned short)(pk_ & 0xffffu); *(unsigned short*)(ow + (32 * (tb_) + crow(r_ + 1, hi)) * SC_OROW) = (unsigned short)(pk_ >> 16); } } while (0)
        for (int n = 0; n < 64; ++n) {
            asm volatile("s_waitcnt lgkmcnt(0)" ::: "memory"); S_BAR();
            const char* bA = lds + MS_A0 + (n & 1) * MS_RA + lane * 16;
            const char* bB = lds + MS_B0 + (n & 1) * MS_RB + lane * 16;
            const char* wv = lds + MS_A0 + (n & 1) * MS_RA + (wid & 1) * 4096 + lane * 8;
            const float eg = egt[n];
            bf16x8 F[3][6];
            u32x2 w[8];
#pragma unroll
            for (int g = 0; g < 4; ++g) { w[g] = *(const u32x2*)(wv + g * 512); w[4 + g] = *(const u32x2*)(wv + 2048 + g * 512); }
            SA_LOAD(0, 0); SA_LOAD(1, 1);
            bf16x8 spa = G_PK(S0, 0), spb = G_PK(S0, 1); S_DECAY2(S0);
            f32x16 O0 = {}, O1 = {};
            bf16x8 up0, up1, up2, up3;
            { typedef unsigned u32x4b __attribute__((ext_vector_type(4)));
              const u32x4b q0 = {w[0][0], w[0][1], w[1][0], w[1][1]}, q1 = {w[2][0], w[2][1], w[3][0], w[3][1]}, q2 = {w[4][0], w[4][1], w[5][0], w[5][1]}, q3 = {w[6][0], w[6][1], w[7][0], w[7][1]};
              up0 = den ? ones : __builtin_bit_cast(bf16x8, q0); up1 = den ? ones : __builtin_bit_cast(bf16x8, q1); up2 = den ? ones : __builtin_bit_cast(bf16x8, q2); up3 = den ? ones : __builtin_bit_cast(bf16x8, q3); }
            STEP_A(0, S1); STEP_A(1, S2); STEP_A(2, S3); STEP_A(3, S3);
            S_BAR();
            G_SBAR();
#pragma unroll
            for (int q = 0; q < 6; ++q) F[0][q] = G_A(bB + q * 1024);
            SK_LOAD(1, 0);
            G_SBAR(); SK_LOAD(2, 1); G_SBAR();
            G_MF(F[0][0], up0, O0); G_MF(F[0][2], up0, O1); G_MF(F[0][1], up1, O0); G_MF(F[0][3], up1, O1); G_MF(F[0][4], up2, O1); G_MF(F[0][5], up3, O1);
            G_SBAR(); SK_LOAD(0, 2); G_SBAR();
            G_MF(F[1][0], up0, S0); G_MF(F[1][1], up0, S1); G_MF(F[1][2], up0, S2); G_MF(F[1][3], up0, S3);
            if (!den) { S_OUT(O0, 0, 0); S_OUT(O0, 0, 8); }
            G_SBAR(); SK_LOAD(1, 3); G_SBAR();
            G_MF(F[2][0], up1, S0); G_MF(F[2][1], up1, S1); G_MF(F[2][2], up1, S2); G_MF(F[2][3], up1, S3);
            if (!den) { S_OUT(O1, 1, 0); S_OUT(O1, 1, 8); }
            else { float* dg = DEN + ((size_t)b * 4096 + (size_t)n * 64) * 4 + h;
#pragma unroll
                for (int r = 0; r < 16; ++r) { if (r32 == 0) dg[(size_t)crow(r, hi) * 4] = O0[r]; if (r32 == 0) dg[(size_t)(32 + crow(r, hi)) * 4] = O1[r]; } }
            G_SBAR();
            G_MF(F[0][0], up2, S0); G_MF(F[0][1], up2, S1); G_MF(F[0][2], up2, S2); G_MF(F[0][3], up2, S3);
            G_MF(F[1][0], up3, S0); G_MF(F[1][1], up3, S1); G_MF(F[1][2], up3, S2); G_MF(F[1][3], up3, S3);
        }
        asm volatile("s_waitcnt lgkmcnt(0)" ::: "memory"); S_BAR();
#undef G_PK
#undef G_A
#undef G_MF
#undef SA_LOAD
#undef SK_LOAD
#undef S_DECAY2
#undef STEP_A
#undef S_OUT
    }
#undef S_BAR
    __syncthreads();
}

__device__ __forceinline__ void mscan_unit(int bh, const unsigned char* GPK, const unsigned char* GWV, const float* GEG, float* HM, float* DEN, char* lds) {
    int tid_ = threadIdx.x; asm volatile("" : "+v"(tid_));
    const int tid = tid_, lane = tid & 63, wid = __builtin_amdgcn_readfirstlane(tid >> 6), r32 = lane & 31, hi = lane >> 5;
    const int b = bh >> 2, h = bh & 3;
    const unsigned lds0 = (unsigned)(uintptr_t)lds;
    if (wid >= 5) {
        const int lw = wid - 5;
#define M_DMA(n_) do { const unsigned char* src_ = GPK + (size_t)(bh * 64 + (n_)) * MPK_BYTES + lane * 16; const unsigned dst_ = lds0 + ((n_) % 3) * MPK_BYTES; \
        for (int p_ = lw; p_ < 38; p_ += 3) __builtin_amdgcn_global_load_lds((const unsigned*)(src_ + p_ * 1024), (__attribute__((address_space(3))) unsigned*)(dst_ + p_ * 1024), 16, 0, 0); } while (0)
#define M_WAIT_OLDER() do { if (lw < 2) asm volatile("s_waitcnt vmcnt(13)" ::: "memory"); else asm volatile("s_waitcnt vmcnt(12)" ::: "memory"); } while (0)
        M_DMA(0); M_DMA(1); M_WAIT_OLDER();
        for (int n = 0; n < 64; ++n) {
            asm volatile("" ::: "memory"); __builtin_amdgcn_s_barrier(); asm volatile("" ::: "memory");
            if (n + 2 < 64) { M_DMA(n + 2); M_WAIT_OLDER(); } else { asm volatile("s_waitcnt vmcnt(0)" ::: "memory"); }
        }
#undef M_DMA
#undef M_WAIT_OLDER
    } else {
        f32x16 S0 = {}, S1 = {}, S2 = {}, S3 = {};
        u32x2 wn[8];
        const unsigned char* wvp = GWV + (size_t)(bh * 64) * MWV_BYTES + ((wid & 3) * 2 * 4) * 512 + lane * 8;
#define M_LDWV(n_) do { const unsigned char* p_ = wvp + (size_t)(n_) * MWV_BYTES; \
        _Pragma("unroll") for (int g_ = 0; g_ < 4; ++g_) { wn[g_] = *(const u32x2*)(p_ + g_ * 512); wn[4 + g_] = *(const u32x2*)(p_ + 2048 + g_ * 512); } } while (0)
#define M_UNPACK(A0, A1) do { _Pragma("unroll") for (int g = 0; g < 4; ++g) { A0[4 * g] = blo(wn[g][0]); A0[4 * g + 1] = bhi(wn[g][0]); A0[4 * g + 2] = blo(wn[g][1]); A0[4 * g + 3] = bhi(wn[g][1]); \
            A1[4 * g] = blo(wn[4 + g][0]); A1[4 * g + 1] = bhi(wn[4 + g][0]); A1[4 * g + 2] = blo(wn[4 + g][1]); A1[4 * g + 3] = bhi(wn[4 + g][1]); } } while (0)
        const float one0 = (r32 == 0) ? 1.f : 0.f;
        f32x16 U0, U1; M_LDWV(0); M_UNPACK(U0, U1);
        float eg = GEG[bh * 64];
        for (int n = 0; n < 64; ++n) {
            asm volatile("" ::: "memory"); __builtin_amdgcn_s_barrier(); asm volatile("" ::: "memory");
            const int nn = (n + 1 < 64) ? n + 1 : 63; M_LDWV(nn); const float egl = GEG[bh * 64 + nn];
            if (wid == 4) {
#pragma unroll
                for (int r = 0; r < 16; ++r) { U0[r] = one0; U1[r] = one0; } }
            const char* buf = lds + (n % 3) * MPK_BYTES + lane * 16;
#define G_PK(X, s_) pack8(X[8 * (s_)], X[8 * (s_) + 1], X[8 * (s_) + 2], X[8 * (s_) + 3], X[8 * (s_) + 4], X[8 * (s_) + 5], X[8 * (s_) + 6], X[8 * (s_) + 7])
            const bf16x8 sp00 = G_PK(S0, 0), sp01 = G_PK(S0, 1), sp10 = G_PK(S1, 0), sp11 = G_PK(S1, 1), sp20 = G_PK(S2, 0), sp21 = G_PK(S2, 1), sp30 = G_PK(S3, 0), sp31 = G_PK(S3, 1);
            S0 *= eg; S1 *= eg; S2 *= eg; S3 *= eg;
#define G_A(off_) (*reinterpret_cast<const bf16x8*>(buf + (off_)))
#define G_MM8(ACC, base_) do { ACC = __builtin_amdgcn_mfma_f32_32x32x16_bf16(G_A((base_) + 0 * 1024), sp00, ACC, 0, 0, 0); ACC = __builtin_amdgcn_mfma_f32_32x32x16_bf16(G_A((base_) + 1 * 1024), sp01, ACC, 0, 0, 0); \
                                ACC = __builtin_amdgcn_mfma_f32_32x32x16_bf16(G_A((base_) + 2 * 1024), sp10, ACC, 0, 0, 0); ACC = __builtin_amdgcn_mfma_f32_32x32x16_bf16(G_A((base_) + 3 * 1024), sp11, ACC, 0, 0, 0); \
                                ACC = __builtin_amdgcn_mfma_f32_32x32x16_bf16(G_A((base_) + 4 * 1024), sp20, ACC, 0, 0, 0); ACC = __builtin_amdgcn_mfma_f32_32x32x16_bf16(G_A((base_) + 5 * 1024), sp21, ACC, 0, 0, 0); \
                                ACC = __builtin_amdgcn_mfma_f32_32x32x16_bf16(G_A((base_) + 6 * 1024), sp30, ACC, 0, 0, 0); ACC = __builtin_amdgcn_mfma_f32_32x32x16_bf16(G_A((base_) + 7 * 1024), sp31, ACC, 0, 0, 0); } while (0)
            f32x16 O0 = {}, O1 = {};
            G_MM8(O0, MPK_QD); G_MM8(O1, MPK_QD + 8192);
            const bf16x8 up00 = G_PK(U0, 0), up01 = G_PK(U0, 1), up10 = G_PK(U1, 0), up11 = G_PK(U1, 1);
            O0 = __builtin_amdgcn_mfma_f32_32x32x16_bf16(G_A(MPK_AT + 0 * 1024), up00, O0, 0, 0, 0); O0 = __builtin_amdgcn_mfma_f32_32x32x16_bf16(G_A(MPK_AT + 1 * 1024), up01, O0, 0, 0, 0);
            O1 = __builtin_amdgcn_mfma_f32_32x32x16_bf16(G_A(MPK_AT + 2 * 1024), up00, O1, 0, 0, 0); O1 = __builtin_amdgcn_mfma_f32_32x32x16_bf16(G_A(MPK_AT + 3 * 1024), up01, O1, 0, 0, 0);
            O1 = __builtin_amdgcn_mfma_f32_32x32x16_bf16(G_A(MPK_AT + 4 * 1024), up10, O1, 0, 0, 0); O1 = __builtin_amdgcn_mfma_f32_32x32x16_bf16(G_A(MPK_AT + 5 * 1024), up11, O1, 0, 0, 0);
#define G_MMS(SX, i_) do { SX = __builtin_amdgcn_mfma_f32_32x32x16_bf16(G_A(MPK_KE + ((i_) * 4 + 0) * 1024), up00, SX, 0, 0, 0); SX = __builtin_amdgcn_mfma_f32_32x32x16_bf16(G_A(MPK_KE + ((i_) * 4 + 1) * 1024), up01, SX, 0, 0, 0); \
                               SX = __builtin_amdgcn_mfma_f32_32x32x16_bf16(G_A(MPK_KE + ((i_) * 4 + 2) * 1024), up10, SX, 0, 0, 0); SX = __builtin_amdgcn_mfma_f32_32x32x16_bf16(G_A(MPK_KE + ((i_) * 4 + 3) * 1024), up11, SX, 0, 0, 0); } while (0)
            G_MMS(S0, 0); G_MMS(S1, 1); G_MMS(S2, 2); G_MMS(S3, 3);
            M_UNPACK(U0, U1); eg = egl;
            const size_t rowb = (size_t)b * 4096 + (size_t)n * 64;
            if (wid < 4) { bf16* og = (bf16*)HM + rowb * 512 + h * 128 + wid * 32 + r32;
#pragma unroll
                for (int r = 0; r < 16; ++r) { og[(size_t)crow(r, hi) * 512] = (bf16)(cvtpk(O0[r], 0.f) & 0xffffu); og[(size_t)(32 + crow(r, hi)) * 512] = (bf16)(cvtpk(O1[r], 0.f) & 0xffffu); }
            } else { float* dg = DEN + rowb * 4 + h;
#pragma unroll
                for (int r = 0; r < 16; ++r) { if (r32 == 0) dg[(size_t)crow(r, hi) * 4] = O0[r]; if (r32 == 0) dg[(size_t)(32 + crow(r, hi)) * 4] = O1[r]; } }
#undef G_PK
#undef G_A
#undef G_MM8
#undef G_MMS
        }
#undef M_LDWV
#undef M_UNPACK
    }
    __syncthreads();
}
#undef G_KSWZ
#undef G_SBAR
#undef G_TR4
#undef G_FR
}

#define GAS __attribute__((address_space(1)))
#define LAS __attribute__((address_space(3)))
typedef unsigned short bf16;
typedef unsigned v4u __attribute__((ext_vector_type(4)));
typedef float f32x4 __attribute__((ext_vector_type(4)));
typedef short bf16x8 __attribute__((ext_vector_type(8)));
typedef GAS unsigned gu32;
typedef GAS unsigned long long gu64;
#define RLX_AGENT __ATOMIC_RELAXED, __HIP_MEMORY_SCOPE_AGENT
#define LDS_WAIT() asm volatile("s_waitcnt lgkmcnt(0)" ::: "memory")
#define VM_WAIT() asm volatile("s_waitcnt vmcnt(0)" ::: "memory")
__device__ __forceinline__ unsigned long long rt() { return __builtin_amdgcn_s_memrealtime(); }
__device__ __forceinline__ unsigned f2bf(float f) { unsigned u = __builtin_bit_cast(unsigned, f); return (u + 0x7fffu + ((u >> 16) & 1u)) >> 16; }
__device__ __forceinline__ unsigned pk2(float lo, float hi) { return f2bf(lo) | (f2bf(hi) << 16); }

#define XB_TMO      128
#define XB_XCNT(j)  (256  + 64 * (j))
#define XB_XSUB(j)  (1280 + 64 * (j))
#define XB_XGEN(j)  (2304 + 64 * (j))
#define XB_TOP      3328
#define XB_TOPGEN   3392
#define XCD_BAR_WORDS 3456
#define XB_SPIN_CAP (1u << 18)

__device__ __forceinline__ unsigned xb_ld(unsigned* p)              { return __hip_atomic_load(p, __ATOMIC_RELAXED, __HIP_MEMORY_SCOPE_AGENT); }
__device__ __forceinline__ unsigned xb_add(unsigned* p, unsigned v) { return __hip_atomic_fetch_add(p, v, __ATOMIC_RELAXED, __HIP_MEMORY_SCOPE_AGENT); }
__device__ __forceinline__ unsigned xb_xcc_id() { return (unsigned)__builtin_amdgcn_s_getreg((3 << 11) | 20) & 0xFu; }
#define XB_SPIN(cond, bar) do { unsigned _sp = 0; while (cond) { __builtin_amdgcn_s_sleep(1); \
    if ((++_sp & 255u) == 0u) { if (xb_ld(&(bar)[XB_TMO])) break; if (_sp > XB_SPIN_CAP) { atomicAdd(&(bar)[XB_TMO], 1u); break; } } } } while (0)

struct XcdBarrier {
    unsigned* bar; unsigned x;
    volatile LAS unsigned* st;
};

__device__ __forceinline__ XcdBarrier xcd_barrier_post(unsigned* bar, volatile LAS unsigned* st) {
    XcdBarrier b; b.bar = bar; b.x = xb_xcc_id(); b.st = st;
    if (threadIdx.x == 0) (void)xb_add(&bar[XB_XCNT(b.x)], 1u);
    return b;
}
__device__ __forceinline__ void xcd_barrier_complete(unsigned* bar, unsigned x, unsigned& nloc, unsigned& nx) {
    const unsigned G = gridDim.x * gridDim.y * gridDim.z;
    unsigned sum, cnt, mine, sp = 0u;
    for (;;) {
        sum = 0u; cnt = 0u; mine = 0u;
#pragma unroll
        for (unsigned j = 0; j < 16; ++j) { const unsigned c = xb_ld(&bar[XB_XCNT(j)]); sum += c; cnt += (c > 0u) ? 1u : 0u; mine = (j == x) ? c : mine; }
        if (sum == G) break;
        __builtin_amdgcn_s_sleep(1);
        if ((++sp & 255u) == 0u) { if (xb_ld(&bar[XB_TMO])) break; if (sp > XB_SPIN_CAP) { atomicAdd(&bar[XB_TMO], 1u); break; } }
    }
    nloc = mine > 0u ? mine : 1u; nx = cnt > 0u ? cnt : 1u;
}

__device__ __forceinline__ void xcd_barrier(const XcdBarrier& b) {
    asm volatile("s_waitcnt vmcnt(0)" ::: "memory");
    __syncthreads();
    if (threadIdx.x == 0) {
        unsigned* bar = b.bar;
        __builtin_amdgcn_s_waitcnt(0);
        unsigned nloc = b.st[0], nx = b.st[1];
        if (nloc == 0u) { xcd_barrier_complete(bar, b.x, nloc, nx); b.st[0] = nloc; b.st[1] = nx; }
        const unsigned old = xb_add(&bar[XB_XSUB(b.x)], 1u);
        const unsigned gen = old / nloc;
        if (old + 1u == (gen + 1u) * nloc) {
            __builtin_amdgcn_fence(__ATOMIC_RELEASE, "agent");
            asm volatile("s_waitcnt vmcnt(0)" ::: "memory");
            const unsigned og = xb_add(&bar[XB_TOP], 1u);
            const unsigned tg = og / nx;
            if (og + 1u == (tg + 1u) * nx) xb_add(&bar[XB_TOPGEN], 1u);
            else XB_SPIN(xb_ld(&bar[XB_TOPGEN]) == tg, bar);
            __builtin_amdgcn_fence(__ATOMIC_ACQUIRE, "agent");
            xb_add(&bar[XB_XGEN(b.x)], 1u);
            asm volatile("s_waitcnt vmcnt(0)" ::: "memory");
        } else {
            XB_SPIN(xb_ld(&bar[XB_XGEN(b.x)]) == gen, bar);
            __builtin_amdgcn_fence(__ATOMIC_ACQUIRE, "agent");
            asm volatile("s_waitcnt vmcnt(0)" ::: "memory");
        }
    }
    __syncthreads();
}
constexpr int DEFER_SPLIT = 3340, DEFER_A = 800;
__device__ const unsigned char FOX_SCHED[12][2] = {{0x2f, 0x2}, {0x1f, 0x1}, {0x7, 0x0}, {0x2e, 0x18}, {0x1e, 0x3}, {0x2d, 0x19}, {0x1d, 0x4}, {0x6, 0x28}, {0x2c, 0x1a}, {0x1c, 0x29}, {0x2b, 0x5}, {0x1b, 0x2a}};
#ifndef REP_PRO
#define REP_PRO 1
#endif
#ifndef REP_G1
#define REP_G1 1
#endif
#ifndef REP_FOX
#define REP_FOX 1
#endif
#ifndef REP_ML
#define REP_ML 1
#endif
#ifndef REP_GDN
#define REP_GDN 1
#endif
#ifndef REP_G3
#define REP_G3 1
#endif
#ifndef REP_PREP
#define REP_PREP 1
#endif
constexpr int NWAVES = 8;
constexpr int DM = 2048, SEQ = 4096, NB = 2, M = NB * SEQ, DEPTH = 2, NIN = 7192, DFF = 5632;
constexpr int LDP = 7168, NPT = 7424;
constexpr int C_MQ = 0, C_MK = 512, C_MV = 1024, C_MO = 1536, C_FQ = 2048, C_FK = 3072, C_FV = 4096, C_GQ = 5120, C_GK = 5632, C_GV = 6144, C_GZ = 6656;
constexpr float NORM_EPS = 1e-6f, QK_SCALE = 0.08838834764831845f;
constexpr size_t MiB = 1u << 20;
constexpr size_t WS_CTL = 0, CTL_ZERO_BYTES = 64 * 1024;
constexpr size_t WL_WIN = 0, WL_WOUT = 29 * MiB, WL_WGU = 37 * MiB, WL_WDN = 81 * MiB, WL_STRIDE = 103 * MiB;
constexpr size_t WS_W = 1 * MiB;
constexpr size_t WS_H = 207 * MiB;
constexpr size_t OUT_HM = 0, OUT_HG = 16 * MiB;
constexpr size_t WS_P = 239 * MiB;
constexpr size_t WS_GR = 351 * MiB;
constexpr size_t WS_GEG = 352 * MiB;
constexpr size_t WS_FST = WS_GEG + 262144;
constexpr size_t WS_GEGM = WS_GEG + 4096, WS_DEN = WS_GEG + 65536;
constexpr size_t WM_GPK = 0, WM_GWV = 19 * MiB;
constexpr size_t WS_CN = 353 * MiB;
constexpr size_t WS_MB = WS_CN + 256 * 1024, WS_MM = WS_CN + 384 * 1024, WS_MC = WS_CN + 512 * 1024;
constexpr size_t WS_GPK = 354 * MiB;
constexpr size_t WS_GWV = 381 * MiB;
constexpr size_t WS_HF = 397 * MiB;
constexpr size_t WS_Y = 429 * MiB;
constexpr size_t WS_PRM = 461 * MiB;
constexpr size_t WS_SS = 462 * MiB;
constexpr size_t WS_END = 463 * MiB;
constexpr int PRM_STRIDE = 16384, PR_MIXN = 0, PR_FFNN = 2048, PR_CONV = 4096, PR_MNORM = 10240, PR_FNORM = 10752, PR_GNORM = 11776, PR_IB = 12288, PR_FB = 12292, PR_XB = 12296, PR_ALOG = 12304, PR_DT = 12308, PR_FINAL = 2 * PRM_STRIDE;
constexpr int CW_BAR = 4096, CW_FIN = 8192, CW_GATE = 12288;
constexpr int RING_OFF = 0, RING_BYTES = 131072;
constexpr int RSTD_OFF = 131072;
constexpr int LDSCTL_OFF = 139264, MISC_OFF = LDSCTL_OFF + 320;
constexpr int LDS_BYTES = 147456;
static_assert(WS_MM - WS_MB == 32768 * 4 && WS_MC - WS_MB == 65536 * 4 && C_FQ - C_FK == -1024 && C_FV - C_FK == 1024 && C_MQ - C_MK == -512 && C_MV - C_MK == 512 && C_MO - C_MK == 1024, "fox::Delta / CB offsets");
static_assert(RSTD_OFF + 5120 <= LDSCTL_OFF, "rstd scratch");
static_assert((M / 256) * (NPT / 256) / 8 == 4 * (NPT / 256) && (M / 256) * (2 * DFF / 256) / 8 == 4 * (2 * DFF / 256) && (M / 256) * (NPT / 256) % 8 == 0 && (M / 256) * (2 * DFF / 256) % 8 == 0, "StaticOrder: with grid % 8 == 0 every tile of workgroup c lies in row-panel group c % 8 (panel_rstd4)");
static_assert(fox::LDS_BYTES <= LDSCTL_OFF && RING_BYTES <= LDSCTL_OFF && MISC_OFF + 128 <= LDS_BYTES && gdn::PREP_LDS <= LDSCTL_OFF && gdn::SC_LDS <= LDSCTL_OFF && gdn::MS_LDS <= LDSCTL_OFF && 3 * gdn::MPK_BYTES <= LDSCTL_OFF && WM_GWV + 512 * (size_t)gdn::MWV_BYTES <= 29 * MiB && 512 * (size_t)gdn::MPK_BYTES <= WM_GWV, "lds map");

__device__ __forceinline__ float bf2f(bf16 v) { return __uint_as_float((unsigned)v << 16); }
__device__ __forceinline__ float bflo(unsigned u) { return __uint_as_float(u << 16); }
__device__ __forceinline__ float bfhi(unsigned u) { return __uint_as_float(u & 0xffff0000u); }
__device__ __forceinline__ int tid_l();
__device__ __forceinline__ float wave_sum(float v) {
#pragma unroll
    for (int o = 1; o < 64; o <<= 1) v += __shfl_xor(v, o);
    return v;
}
__device__ __forceinline__ float sigmoidf_(float x) { return 1.0f / (1.0f + expf(-x)); }
__device__ __forceinline__ float softplusf_(float x) { return fmaxf(x, 0.f) + log1pf(expf(-fabsf(x))); }
__device__ __forceinline__ float logsigmoidf_(float x) { return fminf(x, 0.f) - log1pf(expf(-fabsf(x))); }
__device__ __forceinline__ float softcapf_(float x) { return 15.0f * tanhf(x * (1.0f / 15.0f)); }

__device__ __forceinline__ void transpose_item(const float* W, int ldw, int scol, bf16* WT, int Kd, int drow, int k0, LAS unsigned char* scr, int lane, const float* sk = nullptr) {
    const int q = lane >> 4, c = lane & 15;
    const float* src = W + (size_t)(k0 + 16 * q) * ldw + scol + 4 * c;
    f32x4 v[16];
#pragma unroll
    for (int i = 0; i < 16; ++i) v[i] = __builtin_nontemporal_load((const f32x4*)(src + (size_t)i * ldw));
    if (sk) {
#pragma unroll
        for (int i4 = 0; i4 < 4; ++i4) { const f32x4 g = *(const f32x4*)(sk + k0 + 16 * q + 4 * i4);
            v[4 * i4] *= g[0]; v[4 * i4 + 1] *= g[1]; v[4 * i4 + 2] *= g[2]; v[4 * i4 + 3] *= g[3]; } }
#pragma unroll
    for (int j = 0; j < 4; ++j) {
        v4u o0, o1;
        o0.x = pk2(v[0][j], v[1][j]); o0.y = pk2(v[2][j], v[3][j]); o0.z = pk2(v[4][j], v[5][j]); o0.w = pk2(v[6][j], v[7][j]);
        o1.x = pk2(v[8][j], v[9][j]); o1.y = pk2(v[10][j], v[11][j]); o1.z = pk2(v[12][j], v[13][j]); o1.w = pk2(v[14][j], v[15][j]);
        LAS unsigned char* d = scr + (4 * c + j) * 144 + q * 32;
        *(LAS v4u*)d = o0; *(LAS v4u*)(d + 16) = o1; }
    LDS_WAIT(); asm volatile("" ::: "memory");
    const int nr = lane >> 3, kc = lane & 7;
#pragma unroll
    for (int j = 0; j < 8; ++j) { const v4u o = *(const LAS v4u*)(scr + (nr + 8 * j) * 144 + kc * 16);
        __builtin_nontemporal_store(o, (GAS v4u*)(WT + (size_t)(drow + nr + 8 * j) * Kd + k0 + 8 * kc)); }
    LDS_WAIT(); asm volatile("" ::: "memory");
}
template <int PART>
__device__ __forceinline__ void weights_phase(const float* w_in, const float* w_out, const float* w_gate, const float* w_up, const float* w_down,
                                              bf16* WIN, bf16* WOUT, bf16* WGU, bf16* WDN, LAS unsigned char* lds, int gw, int NGW, int wave, int lane, int gtid, int NGT, const float* nrm, int lo = 0, int hi = 1 << 30) {
    LAS unsigned char* scr = lds + RING_OFF + wave * 16384;
    constexpr int I_A = 32 * 32, I_B = 32 * 48, I_C = 32 * 32, I_O = 32 * 32, I_G = 32 * 88, I_U = 32 * 88, I_D = 88 * 32;
    if constexpr (PART == 0) {
        for (int it = gw; it < I_A + I_B + I_C + I_O; it += NGW) {
            int r = it;
            if (r < I_O) { const int kb = r % 32, nb = r / 32; transpose_item(w_out, DM, 64 * nb, WOUT, DM, 64 * nb, 64 * kb, scr, lane); continue; } r -= I_O;
            if (r < I_A) { const int kb = r % 32, nb = r / 32; transpose_item(w_in, NIN, 64 * nb, WIN, DM, 64 * nb, 64 * kb, scr, lane, nrm); continue; } r -= I_A;
            if (r < I_B) { const int kb = r % 32, nb = r / 32; transpose_item(w_in, NIN, 2056 + 64 * nb, WIN, DM, 2048 + 64 * nb, 64 * kb, scr, lane, nrm); continue; } r -= I_B;
            { const int kb = r % 32, nb = r / 32; transpose_item(w_in, NIN, 5136 + 64 * nb, WIN, DM, 5120 + 64 * nb, 64 * kb, scr, lane, nrm); }
        }
        for (int idx = gtid; idx < 256 * DM; idx += NGT) { const int r = idx / DM, k = idx % DM; float v = 0.f;
            if (r < 24) { const int sc = r < 8 ? 2048 + r : (r < 16 ? 5128 + (r - 8) : 7184 + (r - 16)); v = w_in[(size_t)k * NIN + sc] * nrm[k]; }
            WIN[(size_t)(7168 + r) * DM + k] = (bf16)f2bf(v); }
    } else {
        for (int it = lo + gw; it < (hi < I_O + I_G + I_U + I_D ? hi : I_O + I_G + I_U + I_D); it += NGW) {
            int r = it;
            if (r < I_O) { const int kb = r % 32, nb = r / 32; transpose_item(w_out, DM, 64 * nb, WOUT, DM, 64 * nb, 64 * kb, scr, lane); continue; } r -= I_O;
            if (r < I_G) { const int kb = r % 32, nb = r / 32; transpose_item(w_gate, DFF, 64 * nb, WGU, DM, 256 * (nb >> 1) + 64 * (nb & 1), 64 * kb, scr, lane, nrm); continue; } r -= I_G;
            if (r < I_U) { const int kb = r % 32, nb = r / 32; transpose_item(w_up, DFF, 64 * nb, WGU, DM, 256 * (nb >> 1) + 128 + 64 * (nb & 1), 64 * kb, scr, lane, nrm); continue; } r -= I_U;
            { const int kb = r % 88, nb = r / 88; transpose_item(w_down, DM, 64 * nb, WDN, DFF, 64 * nb, 64 * kb, scr, lane); }
        }
    }
}
__device__ __forceinline__ void rms_row_bf16(const float* xrow, bf16* orow, float* ssrow, int lane) {
    const f32x4* xr = (const f32x4*)xrow + lane;
    f32x4 v[8]; float s = 0.f;
#pragma unroll
    for (int j = 0; j < 8; ++j) { v[j] = xr[64 * j]; s += (v[j].x * v[j].x + v[j].y * v[j].y) + (v[j].z * v[j].z + v[j].w * v[j].w); }
    s = wave_sum(s);
    if (lane < 32) ssrow[lane] = (lane == 0) ? s : 0.f;
    unsigned long long* o8 = (unsigned long long*)orow + lane;
#pragma unroll
    for (int j = 0; j < 8; ++j) o8[64 * j] = (unsigned long long)pk2(v[j].x, v[j].y) | ((unsigned long long)pk2(v[j].z, v[j].w) << 32);
}
__device__ __forceinline__ void rms_row_f32(const bf16* xb, float* xrow, const float* w, const float* ssrow, int lane) {
    f32x4* xr = (f32x4*)xrow + lane; const f32x4* wr = (const f32x4*)w + lane;
    float s = 0.f;
#pragma unroll
    for (int i = 0; i < 32; ++i) s += ssrow[i];
    const float rstd = 1.0f / sqrtf(s * (1.0f / DM) + NORM_EPS);
#pragma unroll
    for (int j = 0; j < 8; ++j) { const unsigned long long q = ((const unsigned long long*)xb)[lane + 64 * j]; const unsigned q0 = (unsigned)q, q1 = (unsigned)(q >> 32);
        const f32x4 v = (f32x4){__uint_as_float(q0 << 16), __uint_as_float(q0 & 0xffff0000u), __uint_as_float(q1 << 16), __uint_as_float(q1 & 0xffff0000u)}, g = wr[64 * j];
        xr[64 * j] = (f32x4){v.x * rstd * g.x, v.y * rstd * g.y, v.z * rstd * g.z, v.w * rstd * g.w}; }
}
__device__ __forceinline__ float wave_incl_sum(float v, int lane) {
#pragma unroll
    for (int o = 1; o < 64; o <<= 1) { const float n = __shfl_up(v, o); if (lane >= o) v += n; }
    return v;
}
__device__ __forceinline__ float wave_incl_max(float v, int lane) {
#pragma unroll
    for (int o = 1; o < 64; o <<= 1) { const float n = __shfl_up(v, o); if (lane >= o) v = fmaxf(v, n); }
    return v;
}
__device__ __forceinline__ void fox_cumsum_block(int bh, const float* GR, const float* fox_bias, float* CN, LAS float* sc) {
    const int tl = tid_l(), lane = tl & 63, wave = __builtin_amdgcn_readfirstlane(tl >> 6);
    const int b = bh >> 3, h = bh & 7; const float bias = fox_bias[h];
    float raw[8];
#pragma unroll
    for (int k = 0; k < 8; ++k) raw[k] = GR[(b * SEQ + wave * 512 + k * 64 + lane) * 32 + 8 + h];
    float F[8]; float carry = 0.f;
#pragma unroll
    for (int k = 0; k < 8; ++k) { const float s = wave_incl_sum(logsigmoidf_(raw[k] + bias), lane); F[k] = carry + s; carry += __shfl(s, 63); }
    if (lane == 0) sc[wave] = carry;
    __syncthreads();
    float pre = 0.f;
#pragma unroll
    for (int w2 = 0; w2 < 8; ++w2) if (w2 < wave) pre += sc[w2];
#pragma unroll
    for (int k = 0; k < 8; ++k) CN[bh * SEQ + wave * 512 + k * 64 + lane] = -(pre + F[k]) * (1.0f / QK_SCALE);
    __syncthreads();
}
__device__ __forceinline__ void mlstm_scan_block(int bh, const float* GR, const float* ibias, const float* fbias, float* MB, float* MM, float* MC, LAS float* sc) {
    const int tl = tid_l(), lane = tl & 63, wave = __builtin_amdgcn_readfirstlane(tl >> 6);
    const int b = bh >> 2, h = bh & 3; const float ib = ibias[h], fb = fbias[h]; constexpr float L2E = 1.4426950408889634f;
    float ri[8], rf[8];
#pragma unroll
    for (int k = 0; k < 8; ++k) { const int row = (b * SEQ + wave * 512 + k * 64 + lane) * 32; ri[k] = GR[row + h]; rf[k] = GR[row + 4 + h]; }
    float F[8], B2[8], LM[8]; float carry = 0.f, cmax = -__builtin_inff();
#pragma unroll
    for (int k = 0; k < 8; ++k) { const float it = softcapf_(ri[k] + ib), lf = logsigmoidf_(softcapf_(rf[k] + fb));
        const float s = wave_incl_sum(lf, lane); F[k] = carry + s; carry += __shfl(s, 63);
        B2[k] = (it - F[k]) * L2E; const float mx = wave_incl_max(B2[k], lane); LM[k] = fmaxf(cmax, mx); cmax = fmaxf(cmax, __shfl(mx, 63)); }
    if (lane == 0) { sc[wave] = carry; sc[8 + wave] = cmax; }
    __syncthreads();
    float pre = 0.f, mprev = -__builtin_inff(), run = 0.f;
#pragma unroll
    for (int w2 = 0; w2 < 8; ++w2) if (w2 < wave) { mprev = fmaxf(mprev, sc[8 + w2] - run * L2E); run += sc[w2]; }
    pre = run;
#pragma unroll
    for (int k = 0; k < 8; ++k) { const int o = bh * SEQ + wave * 512 + k * 64 + lane;
        const float b2 = B2[k] - pre * L2E, m2 = fmaxf(mprev, LM[k] - pre * L2E), Fg = pre + F[k];
        MB[o] = b2; MM[o] = m2; MC[o] = exp2f(-(Fg * L2E + m2)); }
    __syncthreads();
}
__device__ __forceinline__ float half_sum(float v) { v += __shfl_xor(v, 1); v += __shfl_xor(v, 2); v += __shfl_xor(v, 4); v += __shfl_xor(v, 8); v += __shfl_xor(v, 16); return v; }
__device__ __forceinline__ float fsig(float x) { return __builtin_amdgcn_rcpf(1.0f + __expf(-x)); }
__device__ __forceinline__ void post_row(int m, const bf16* P, const float* HM, const float* HG, bf16* Y, const float* wm, const float* wg, const float* DEN, const float* MC,
                                         const float* PO, const float* FST, const float* wf, int lane) {
    const bf16* pr = P + (size_t)m * LDP; unsigned long long* yr = (unsigned long long*)(Y + (size_t)m * DM) + lane;
    if ((m & 4095) >= 2048) {
        const int b = m >> 12, tr = (m & 4095) - 2048; constexpr float C2 = 1.4426950408889634f * QK_SCALE;
        const size_t ra = ((size_t)(0 * 2 + b) * 2048 + tr), rb = ((size_t)(1 * 2 + b) * 2048 + tr);
        f32x4 oa[4], ob[4], wq[4]; float wa[4], wb[4];
#pragma unroll
        for (int j = 0; j < 4; ++j) { const int head = 2 * j + (lane >> 5);
            oa[j] = *(const f32x4*)(PO + ra * 1024 + 256 * j + 4 * lane); ob[j] = *(const f32x4*)(PO + rb * 1024 + 256 * j + 4 * lane); wq[j] = *(const f32x4*)(wf + 256 * j + 4 * lane);
            const float ma = FST[(ra * 8 + head) * 2], la = FST[(ra * 8 + head) * 2 + 1], mb = FST[(rb * 8 + head) * 2], lb = FST[(rb * 8 + head) * 2 + 1];
            const float mx = fmaxf(ma, mb); wa[j] = la * __builtin_amdgcn_exp2f((ma - mx) * C2); wb[j] = lb * __builtin_amdgcn_exp2f((mb - mx) * C2); }
#pragma unroll
        for (int j = 0; j < 4; ++j) { const float inv = __builtin_amdgcn_rcpf(wa[j] + wb[j]); const f32x4 x = (oa[j] * wa[j] + ob[j] * wb[j]) * inv;
            const float rstd = 1.0f / sqrtf(half_sum((x[0] * x[0] + x[1] * x[1]) + (x[2] * x[2] + x[3] * x[3])) * (1.0f / 128.0f) + NORM_EPS);
            yr[128 + 64 * j] = (unsigned long long)pk2(x[0] * rstd * wq[j][0], x[1] * rstd * wq[j][1]) | ((unsigned long long)pk2(x[2] * rstd * wq[j][2], x[3] * rstd * wq[j][3]) << 32); }
    }
    f32x4 v[4], w[4]; unsigned long long gt[4];
#pragma unroll
    for (int j = 0; j < 2; ++j) { { const unsigned long long q = *(const unsigned long long*)((const bf16*)HM + (size_t)m * 512 + 256 * j + 4 * lane); v[j] = (f32x4){bflo((unsigned)q), bfhi((unsigned)q), bflo((unsigned)(q >> 32)), bfhi((unsigned)(q >> 32))}; }
        w[j] = *(const f32x4*)(wm + 256 * j + 4 * lane); gt[j] = *(const unsigned long long*)(pr + C_MO + 256 * j + 4 * lane);
        { const unsigned long long q = *(const unsigned long long*)((const bf16*)HG + (size_t)m * 512 + 256 * j + 4 * lane); v[2 + j] = (f32x4){bflo((unsigned)q), bfhi((unsigned)q), bflo((unsigned)(q >> 32)), bfhi((unsigned)(q >> 32))}; } w[2 + j] = *(const f32x4*)(wg + 256 * j + 4 * lane); gt[2 + j] = *(const unsigned long long*)(pr + C_GZ + 256 * j + 4 * lane); }
#pragma unroll
    for (int j = 0; j < 4; ++j) { f32x4 x = v[j]; float o0, o1, o2, o3; const unsigned g0 = (unsigned)gt[j], g1 = (unsigned)(gt[j] >> 32);
        if (j < 2) { const int head = 2 * j + (lane >> 5);
            x = x * __builtin_amdgcn_rcpf(fmaxf(fabsf(DEN[(size_t)m * 4 + head]), MC[((size_t)(m >> 12) * 4 + head) * SEQ + (m & 4095)]));
            const float mean = half_sum((x[0] + x[1]) + (x[2] + x[3])) * (1.0f / 128.0f); x = x - mean;
            const float rstd = 1.0f / sqrtf(half_sum((x[0] * x[0] + x[1] * x[1]) + (x[2] * x[2] + x[3] * x[3])) * (1.0f / 128.0f) + NORM_EPS);
            o0 = x[0] * rstd * w[j][0] * fsig(bflo(g0)); o1 = x[1] * rstd * w[j][1] * fsig(bfhi(g0)); o2 = x[2] * rstd * w[j][2] * fsig(bflo(g1)); o3 = x[3] * rstd * w[j][3] * fsig(bfhi(g1));
        } else { const float rstd = 1.0f / sqrtf(half_sum((x[0] * x[0] + x[1] * x[1]) + (x[2] * x[2] + x[3] * x[3])) * (1.0f / 128.0f) + NORM_EPS);
            const float z0 = bflo(g0), z1 = bfhi(g0), z2 = bflo(g1), z3 = bfhi(g1);
            o0 = x[0] * rstd * w[j][0] * z0 * fsig(z0); o1 = x[1] * rstd * w[j][1] * z1 * fsig(z1); o2 = x[2] * rstd * w[j][2] * z2 * fsig(z2); o3 = x[3] * rstd * w[j][3] * z3 * fsig(z3); }
        yr[(j < 2 ? 64 * j : 384 + 64 * (j - 2))] = (unsigned long long)pk2(o0, o1) | ((unsigned long long)pk2(o2, o3) << 32); }
}

__device__ __forceinline__ GAS unsigned char* launder(unsigned char* p) { GAS unsigned char* g = (GAS unsigned char*)p; asm volatile("" : "+s"(g)); return g; }
__device__ __forceinline__ int tid_l() { int t = threadIdx.x; asm volatile("" : "+v"(t)); return t; }
__device__ __forceinline__ void copy_f32(const float* src, float* dst, int n, int gtid, int NGT) { for (int i = gtid; i < n; i += NGT) dst[i] = src[i]; }
struct Args { const float* in[18]; float* out; unsigned char* ws; };

template <int L>
__device__ __forceinline__ void layer_body(unsigned char* ws_, const float* xin, float* X, const XcdBarrier& bar, unsigned char* lds,
                                           const float* w_out, const float* w_gate, const float* w_up, const float* w_down, const float* w_in_next, const float* nffn, const float* nmix_next) {
    LAS unsigned char* ldsl = (LAS unsigned char*)lds;
#ifndef NO_PH1
    for (int rep_ = 0; rep_ < REP_G1; ++rep_)
    { GAS unsigned char* w = launder(ws_);
      pg8::Gemm g{(const bf16*)(w + WS_H), (const bf16*)(w + WS_W + L * WL_STRIDE + WL_WIN), M, NPT, DM}; pg8::StaticOrder S; S.init(M, NPT, gridDim.x, blockIdx.x, 4, 28);
      pg8::panel_rstd4((const float*)(w + WS_SS), blockIdx.x & 7, (LAS float*)(ldsl + RSTD_OFF));
      pg8::EpiProj E{(bf16*)(w + WS_P), (float*)(w + WS_GR), (const float*)(w + WS_SS), (LAS float*)(ldsl + RSTD_OFF), (unsigned*)(w + WS_CTL) + CW_GATE + 64 * L, (int)(blockIdx.x & 7)};
      pg8::gemm_phase<pg8::EpiProj, pg8::StaticOrder, true, true>(ldsl + RING_OFF, g, S, E);
      if (blockIdx.x >= 160 && blockIdx.x < 184) {
        unsigned* gc = (unsigned*)(w + WS_CTL) + CW_GATE + 64 * L; unsigned* tmo = (unsigned*)(w + WS_CTL) + CW_BAR + XB_TMO;
        if (threadIdx.x == 0) { unsigned sp = 0;
          while (__hip_atomic_load(gc, __ATOMIC_RELAXED, __HIP_MEMORY_SCOPE_AGENT) < 32u) { __builtin_amdgcn_s_sleep(1);
            if ((++sp & 255u) == 0u) { if (__hip_atomic_load(tmo, __ATOMIC_RELAXED, __HIP_MEMORY_SCOPE_AGENT)) break; if (sp > (1u << 18)) { atomicAdd(tmo, 1u); break; } } }
          __builtin_amdgcn_fence(__ATOMIC_ACQUIRE, "agent"); asm volatile("s_waitcnt vmcnt(0)" ::: "memory"); }
        __syncthreads();
        const float* prm = (const float*)(w + WS_PRM) + L * PRM_STRIDE; const float* GR = (const float*)(w + WS_GR); const int sb = blockIdx.x - 160;
        if (sb < 16) fox_cumsum_block(sb, GR, prm + PR_XB, (float*)(w + WS_CN), (LAS float*)(ldsl + RSTD_OFF));
        else mlstm_scan_block(sb - 16, GR, prm + PR_IB, prm + PR_FB, (float*)(w + WS_MB), (float*)(w + WS_MM), (float*)(w + WS_MC), (LAS float*)(ldsl + RSTD_OFF));
        __syncthreads(); }
      if (blockIdx.x >= 160) {
        const int tid = tid_l(), lane = tid & 63, wave = __builtin_amdgcn_readfirstlane(tid >> 6); unsigned char* wl = ws_ + WS_W + L * WL_STRIDE;
        if (blockIdx.x >= 184)
          weights_phase<1>(nullptr, w_out, w_gate, w_up, w_down, nullptr, (bf16*)(wl + WL_WOUT), (bf16*)(wl + WL_WGU), (bf16*)(wl + WL_WDN), ldsl,
                           (blockIdx.x - 184) * NWAVES + wave, ((int)gridDim.x - 184) * NWAVES, wave, lane, 0, 1, nffn, 1024, 1024 + DEFER_A);
        weights_phase<1>(nullptr, w_out, w_gate, w_up, w_down, nullptr, (bf16*)(wl + WL_WOUT), (bf16*)(wl + WL_WGU), (bf16*)(wl + WL_WDN), ldsl,
                         (blockIdx.x - 160) * NWAVES + wave, ((int)gridDim.x - 160) * NWAVES, wave, lane, 0, 1, nffn, 1024 + DEFER_A, 1024 + DEFER_SPLIT); } }
#endif
    xcd_barrier(bar);
#ifndef NO_PH2
    for (int rep_ = 0; rep_ < REP_PREP; ++rep_)
    { GAS unsigned char* w = launder(ws_); const int tl = tid_l(), lane = tl & 63, gw = blockIdx.x * NWAVES + (tl >> 6);
      const float* prm = (const float*)(w + WS_PRM) + L * PRM_STRIDE; const float* GR = (const float*)(w + WS_GR);
      for (int u = blockIdx.x; u < 512; u += gridDim.x)
          gdn::prep_unit(u, (const bf16*)(w + WS_P), GR, prm + PR_CONV, prm + PR_ALOG, prm + PR_DT, (unsigned char*)(w + WS_GPK), (float*)(w + WS_GWV), (float*)(w + WS_GEG), (char*)lds); }
#endif
    { GAS unsigned char* w = launder(ws_); unsigned char* wm = (unsigned char*)(w + WS_W + L * WL_STRIDE + WL_WIN);
      for (int u = blockIdx.x; u < 512; u += gridDim.x)
          gdn::mlstm_prep_unit(u, (const bf16*)(w + WS_P), (const float*)(w + WS_MB), (const float*)(w + WS_MM), wm + WM_GPK, wm + WM_GWV, (float*)(w + WS_GEGM), (char*)lds); }
    xcd_barrier(bar);
    { const int bx = blockIdx.x;
#ifndef NO_FOX
      if (bx < 192) for (int rep_ = 0; rep_ < REP_FOX; ++rep_) {
        GAS unsigned char* w = launder(ws_); const bf16* P = (const bf16*)(w + WS_P);
        const int kk = bx >> 3, bh = (bx & 7) + 8 * (kk / 12), k12 = kk % 12, b = bh >> 3, h = bh & 7;
        for (int pass = 0; pass < 2; ++pass) { const int code = FOX_SCHED[k12][pass], qb = code & 15, part = code >> 4, ntall = 4 * (qb + 1);
            fox::BlockRef r;
            r.K = P + (size_t)b * SEQ * LDP + C_FK + h * 128; r.CB = (const float*)(w + WS_CN) + (size_t)bh * SEQ;
            r.Y = (bf16*)(w + WS_Y) + (size_t)b * SEQ * DM + 512 + h * 128; r.NW = (const float*)(w + WS_PRM) + L * PRM_STRIDE + PR_FNORM + h * 128; r.P0 = qb * 256;
            r.t0 = (part == 2) ? ntall / 2 : 0; r.nt = (part == 0) ? ntall : ntall / 2;
            r.PO = part ? (float*)(w + WS_HF) + ((size_t)((part - 1) * 2 + b) * 2048) * 1024 + h * 128 : (float*)nullptr;
            r.ST = (float*)(w + WS_FST) + ((size_t)((part - 1 < 0 ? 0 : part - 1) * 2 + b) * 2048 * 8 + h) * 2;
            fox::Seam S; fox::prime<false>(r, (char*)lds, S); fox::block<false>(r, (char*)lds, S); }
      }
#endif
#ifndef NO_ML
      if ((bx >= 192 && bx < 200) || (bx >= 216 && bx < 224)) {
        GAS unsigned char* w = launder(ws_); unsigned char* wm = (unsigned char*)(w + WS_W + L * WL_STRIDE + WL_WIN);
        gdn::mscan2_unit(bx & 7, bx >= 216 ? 1 : 0, wm + WM_GPK, wm + WM_GWV, (const float*)(w + WS_GEGM), (float*)((unsigned char*)X + OUT_HM), (float*)(w + WS_DEN), (char*)lds); }
#endif
      if (bx >= 224) {
        const int tid = tid_l(), lane = tid & 63, wave = __builtin_amdgcn_readfirstlane(tid >> 6); unsigned char* wl = ws_ + WS_W + L * WL_STRIDE;
        weights_phase<1>(nullptr, w_out, w_gate, w_up, w_down, nullptr, (bf16*)(wl + WL_WOUT), (bf16*)(wl + WL_WGU), (bf16*)(wl + WL_WDN), ldsl,
                         (bx - 224) * NWAVES + wave, ((int)gridDim.x - 224) * NWAVES, wave, lane, 0, 1, nffn, 1024 + DEFER_SPLIT); }
#ifndef NO_GDN
      if (bx >= 200 && bx < 216) for (int rep_ = 0; rep_ < REP_GDN; ++rep_) { GAS unsigned char* w = launder(ws_);
        gdn::scan_unit((bx - 200) & 7, (bx - 200) >> 3, (const unsigned char*)(w + WS_GPK), (const float*)(w + WS_GWV), (const float*)(w + WS_GEG), (float*)((unsigned char*)X + OUT_HG), (char*)lds); }
#endif
    }
    xcd_barrier(bar);
#ifndef NO_PH4
    { GAS unsigned char* w = launder(ws_); const int tl = tid_l(), lane = tl & 63, gw = blockIdx.x * NWAVES + (tl >> 6), NGW = gridDim.x * NWAVES;
      const float* prm = (const float*)(w + WS_PRM) + L * PRM_STRIDE;
      for (int m = gw; m < M; m += NGW) post_row(m, (const bf16*)(w + WS_P), (const float*)((const unsigned char*)X + OUT_HM), (const float*)((const unsigned char*)X + OUT_HG), (bf16*)(w + WS_Y), prm + PR_MNORM, prm + PR_GNORM, (const float*)(w + WS_DEN), (const float*)(w + WS_MC),
                                                 (const float*)(w + WS_HF), (const float*)(w + WS_FST), prm + PR_FNORM, lane); }
#endif
    xcd_barrier(bar);
#ifndef NO_PH5
    { GAS unsigned char* w = launder(ws_);
      pg8::Gemm g{(const bf16*)(w + WS_Y), (const bf16*)(w + WS_W + L * WL_STRIDE + WL_WOUT), M, DM, DM}; pg8::StaticOrder S; S.init(M, DM, gridDim.x, blockIdx.x); pg8::EpiRes<L == 0> E{(L == 0) ? (const void*)xin : (const void*)(w + WS_H), (bf16*)(w + WS_H), (float*)(w + WS_SS)};
      pg8::gemm_phase<pg8::EpiRes<L == 0>, pg8::StaticOrder, true, true>(ldsl + RING_OFF, g, S, E); }
#endif
    xcd_barrier(bar);
#ifndef NO_PH7
    for (int rep_ = 0; rep_ < REP_G3; ++rep_)
    { GAS unsigned char* w = launder(ws_);
      pg8::Gemm g{(const bf16*)(w + WS_H), (const bf16*)(w + WS_W + L * WL_STRIDE + WL_WGU), M, 2 * DFF, DM}; pg8::StaticOrder S; S.init(M, 2 * DFF, gridDim.x, blockIdx.x);
      pg8::panel_rstd4((const float*)(w + WS_SS), blockIdx.x & 7, (LAS float*)(ldsl + RSTD_OFF)); pg8::EpiSwiglu E{(bf16*)(w + WS_P), (const float*)(w + WS_SS), (LAS float*)(ldsl + RSTD_OFF), (int)(blockIdx.x & 7)};
      pg8::gemm_phase<pg8::EpiSwiglu, pg8::StaticOrder, true, true>(ldsl + RING_OFF, g, S, E);
      if (L + 1 < DEPTH && blockIdx.x >= 128) {
        const int tid = tid_l(), lane = tid & 63, wave = __builtin_amdgcn_readfirstlane(tid >> 6); unsigned char* wl = ws_ + WS_W + (L + 1) * WL_STRIDE;
        const int gwq = (blockIdx.x - 128) * NWAVES + wave, nwq = ((int)gridDim.x - 128) * NWAVES;
        weights_phase<0>(w_in_next, w_out + (size_t)DM * DM, nullptr, nullptr, nullptr, (bf16*)(wl + WL_WIN), (bf16*)(wl + WL_WOUT), nullptr, nullptr, ldsl,
                         gwq, nwq, wave, lane, gwq * 64 + lane, nwq * 64, nmix_next); } }
#endif
    xcd_barrier(bar);
#ifndef NO_PH8
    { GAS unsigned char* w = launder(ws_);
      pg8::Gemm g{(const bf16*)(w + WS_P), (const bf16*)(w + WS_W + L * WL_STRIDE + WL_WDN), M, DM, DFF}; pg8::StaticOrder S; S.init(M, DM, gridDim.x, blockIdx.x); pg8::EpiRes<false> E{(const void*)(w + WS_H), (bf16*)(w + WS_H), (float*)(w + WS_SS)};
      if (L + 1 == DEPTH && gridDim.x >= 256) {
        pg8::EpiFinal F{(const bf16*)(w + WS_H), X, (const float*)(w + WS_PRM) + PR_FINAL, (float*)(w + WS_SS), (unsigned*)(w + WS_CTL) + CW_FIN, (unsigned*)(w + WS_CTL) + CW_BAR + XB_TMO, (LAS float*)(ldsl + RSTD_OFF)};
        pg8::gemm_phase<pg8::EpiFinal, pg8::StaticOrder, true, true>(ldsl + RING_OFF, g, S, F); return; }
      pg8::gemm_phase<pg8::EpiRes<false>, pg8::StaticOrder, true, true>(ldsl + RING_OFF, g, S, E); }
#endif
    xcd_barrier(bar);
}

__global__ void __launch_bounds__(NWAVES * 64, 2) hybrid_fwd(Args args) {
    extern __shared__ __attribute__((aligned(16))) unsigned char lds[];
    LAS unsigned char* ldsl = (LAS unsigned char*)lds;
    volatile LAS unsigned* MISC = (volatile LAS unsigned*)(ldsl + MISC_OFF);
    unsigned char* ws = args.ws;
    for (int u = threadIdx.x; u < (LDS_BYTES - LDSCTL_OFF) / 4; u += NWAVES * 64) ((LAS unsigned*)(ldsl + LDSCTL_OFF))[u] = 0u;
    __syncthreads();
    XcdBarrier bar = xcd_barrier_post((unsigned*)(ws + WS_CTL) + CW_BAR, MISC + 8);
#ifndef NO_PRO
    for (int rep_ = 0; rep_ < REP_PRO; ++rep_)
    { const int tid = tid_l(), lane = tid & 63, wave = __builtin_amdgcn_readfirstlane(tid >> 6);
      const int gw = blockIdx.x * NWAVES + wave, NGW = gridDim.x * NWAVES, gtid = blockIdx.x * (NWAVES * 64) + tid, NGT = gridDim.x * NWAVES * 64;
      { unsigned char* wl = ws + WS_W;
        weights_phase<0>(args.in[2], args.in[12], nullptr, nullptr, nullptr, (bf16*)(wl + WL_WIN), (bf16*)(wl + WL_WOUT), nullptr, nullptr, ldsl, gw, NGW, wave, lane, gtid, NGT, args.in[1]); }
#pragma unroll
      for (int l = 0; l < DEPTH; ++l) {
        float* prm = (float*)(ws + WS_PRM) + l * PRM_STRIDE;
        copy_f32(args.in[1] + l * DM, prm + PR_MIXN, DM, gtid, NGT); copy_f32(args.in[13] + l * DM, prm + PR_FFNN, DM, gtid, NGT);
        copy_f32(args.in[6] + l * 6144, prm + PR_CONV, 6144, gtid, NGT); copy_f32(args.in[9] + l * 512, prm + PR_MNORM, 512, gtid, NGT);
        copy_f32(args.in[10] + l * 1024, prm + PR_FNORM, 1024, gtid, NGT); copy_f32(args.in[11] + l * 512, prm + PR_GNORM, 512, gtid, NGT);
        copy_f32(args.in[3] + l * 4, prm + PR_IB, 4, gtid, NGT); copy_f32(args.in[4] + l * 4, prm + PR_FB, 4, gtid, NGT); copy_f32(args.in[5] + l * 8, prm + PR_XB, 8, gtid, NGT);
        copy_f32(args.in[7] + l * 4, prm + PR_ALOG, 4, gtid, NGT); copy_f32(args.in[8] + l * 4, prm + PR_DT, 4, gtid, NGT);
      }
      copy_f32(args.in[17], (float*)(ws + WS_PRM) + PR_FINAL, DM, gtid, NGT);
      for (int m = gw; m < M; m += NGW) rms_row_bf16(args.in[0] + (size_t)m * DM, (bf16*)(ws + WS_H) + (size_t)m * DM, (float*)(ws + WS_SS) + (size_t)m * 32, lane); }
#endif
    xcd_barrier(bar);
    layer_body<0>(ws, args.in[0], args.out, bar, lds, args.in[12], args.in[14], args.in[15], args.in[16], args.in[2] + (size_t)DM * NIN, args.in[13], args.in[1] + DM);
    layer_body<1>(ws, args.out, args.out, bar, lds, args.in[12] + (size_t)DM * DM, args.in[14] + (size_t)DM * DFF, args.in[15] + (size_t)DM * DFF, args.in[16] + (size_t)DFF * DM, nullptr, args.in[13] + DM, nullptr);
    if (gridDim.x < 256)
    { GAS unsigned char* w = launder(ws); const int tl = tid_l(), lane = tl & 63, gw = blockIdx.x * NWAVES + (tl >> 6), NGW = gridDim.x * NWAVES;
      const float* prm = (const float*)(w + WS_PRM) + PR_FINAL; float* X = args.out;
      for (int m = gw; m < M; m += NGW) rms_row_f32((const bf16*)(w + WS_H) + (size_t)m * DM, X + (size_t)m * DM, prm, (const float*)(w + WS_SS) + (size_t)m * 32, lane); }
}

extern "C" void kernel_launch(void* const* d_in, const int* in_sizes, int n_in, void* d_out, int out_size, void* d_ws, size_t ws_size, hipStream_t stream) {
    static int grid = 0;
    if (grid == 0) {
        if (n_in != 18 || in_sizes[0] != M * DM || out_size != M * DM || ws_size < WS_END) {
            fprintf(stderr, "kernel_launch: unexpected shapes: n_in %d in0 %d out %d ws %zu (need >= %zu)\n", n_in, n_in > 0 ? in_sizes[0] : -1, out_size, ws_size, (size_t)WS_END); grid = -1; return; }
        int dev = 0, cus = 0, per_cu = 0;
        if (hipGetDevice(&dev) != hipSuccess || hipDeviceGetAttribute(&cus, hipDeviceAttributeMultiprocessorCount, dev) != hipSuccess) { grid = -1; return; }
        if (hipFuncSetAttribute((const void*)hybrid_fwd, hipFuncAttributeMaxDynamicSharedMemorySize, LDS_BYTES) != hipSuccess) { fprintf(stderr, "kernel_launch: hipFuncSetAttribute failed\n"); grid = -1; return; }
        if (hipOccupancyMaxActiveBlocksPerMultiprocessor(&per_cu, (const void*)hybrid_fwd, NWAVES * 64, LDS_BYTES) != hipSuccess || per_cu < 1) {
            fprintf(stderr, "kernel_launch: occupancy query says %d blocks per CU\n", per_cu); (void)hipGetLastError(); grid = -1; return; }
        grid = cus;
        if (grid < 232 || grid % 8 != 0) { fprintf(stderr, "kernel_launch: unsupported CU count %d\n", cus); grid = -1; return; }
    }
    if (grid < 0) return;
    if (hipMemsetAsync((char*)d_ws + WS_CTL, 0, CTL_ZERO_BYTES, stream) != hipSuccess) return;
    Args a{};
    for (int i = 0; i < 18; ++i) a.in[i] = (const float*)d_in[i];
    a.out = (float*)d_out; a.ws = (unsigned char*)d_ws;
    hipLaunchKernelGGL(hybrid_fwd, dim3(grid), dim3(NWAVES * 64), LDS_BYTES, stream, a);
}
```
